# Optimizing an MI355X kernel written in HIP

```python
import jax, jax.numpy as jnp
from jax import lax
import numpy as np

D_MODEL = 1024
BATCH = 8
SEQ = 4096
DEPTH = 1

CHUNK = 64
LEFT_CHUNKS = 8
BAND = (LEFT_CHUNKS + 1) * CHUNK
HEAD_DIM = 64
RWKV_HEADS = 8
ATTN_HEADS = 8
RWKV_WIDTH = RWKV_HEADS * HEAD_DIM
ATTN_WIDTH = ATTN_HEADS * HEAD_DIM
DECAY_RANK = 64
ICLR_RANK = 64
GATE_RANK = 128
RWKV_COLS = 3 * RWKV_WIDTH + DECAY_RANK + ICLR_RANK + GATE_RANK
ATTN_COLS = 3 * ATTN_WIDTH
GATE_COLS = 2 * D_MODEL
IN_COLS = RWKV_COLS + ATTN_COLS + GATE_COLS
MAX_REL = 128
REL_TABLE = (CHUNK - 1) + MAX_REL + 1
D_FF = 2816
CONV_W = 3
PLE_DIM = 256
NORM_EPS = 1e-6
GN_EPS = 64e-5
NEG_INF = -1e30

kernel_name = "hybrid_rwkv7_chunkattn_convglu_block"


def rms_norm(x, g):
    xf = x.astype(jnp.float32)
    y = xf * lax.rsqrt(jnp.mean(xf * xf, axis=-1, keepdims=True) + NORM_EPS)
    return (y * g.astype(jnp.float32)).astype(x.dtype)


def token_shift(z):
    return jnp.pad(z, ((0, 0), (1, 0), (0, 0)))[:, :-1]


def rwkv7_time_mix(z, mu, w0, w2, a0, a2, g2, k_k, k_a, r_k, lnx_w, lnx_b):
    B, T, _ = z.shape
    H, N = RWKV_HEADS, HEAD_DIM
    zs = z + (token_shift(z) - z) * mu
    W = RWKV_WIDTH
    r, k, v, wd, ad, gd = jnp.split(
        zs, [W, 2 * W, 3 * W, 3 * W + DECAY_RANK, 3 * W + DECAY_RANK + ICLR_RANK], axis=-1)
    f32 = jnp.float32
    w_log = -jax.nn.softplus(-(w0 + jnp.tanh(wd) @ w2).astype(f32)) - 0.5
    decay = jnp.exp(-jnp.exp(w_log))
    a = jax.nn.sigmoid((a0 + ad @ a2).astype(f32))
    g = jax.nn.sigmoid(gd) @ g2
    r, k, v = r.astype(f32), k.astype(f32), v.astype(f32)
    kk = (k * k_k.astype(f32)).reshape(B, T, H, N)
    kk = kk / jnp.maximum(jnp.sqrt(jnp.sum(kk * kk, axis=-1, keepdims=True)), 1e-12)
    k = k * (1.0 + (a - 1.0) * k_a.astype(f32))
    heads = lambda t: t.reshape(B, T, H, N)
    r, k, v, a, decay = heads(r), heads(k), heads(v), heads(a), heads(decay)
    tm = lambda t: jnp.moveaxis(t, 1, 0)

    def step(S, inp):
        r_t, d_t, k_t, v_t, kk_t, a_t = inp
        sa = jnp.einsum('bhij,bhj->bhi', S, -kk_t)
        S = (S * d_t[:, :, None, :]
             + sa[..., :, None] * (kk_t * a_t)[..., None, :]
             + v_t[..., :, None] * k_t[..., None, :])
        y_t = jnp.einsum('bhij,bhj->bhi', S, r_t)
        return S, y_t

    S0 = jnp.zeros((B, H, N, N), f32)
    _, y = lax.scan(step, S0, (tm(r), tm(decay), tm(k), tm(v), tm(kk), tm(a)))
    y = jnp.moveaxis(y, 0, 1)
    mean = jnp.mean(y, axis=-1, keepdims=True)
    var = jnp.mean(jnp.square(y - mean), axis=-1, keepdims=True)
    y = (y - mean) * lax.rsqrt(var + GN_EPS)
    y = y * lnx_w.astype(f32).reshape(H, N) + lnx_b.astype(f32).reshape(H, N)
    bonus = jnp.sum(r * k * r_k.astype(f32), axis=-1, keepdims=True) * v
    y = (y + bonus).reshape(B, T, W)
    return (y * g.astype(f32)).astype(z.dtype)


def chunk_attention(q, k, v, rel_bias):
    B, T, H, Dh = q.shape
    NC = T // CHUNK
    pad = LEFT_CHUNKS * CHUNK
    kp = jnp.pad(k, ((0, 0), (pad, 0), (0, 0), (0, 0)))
    vp = jnp.pad(v, ((0, 0), (pad, 0), (0, 0), (0, 0)))
    qc = jnp.moveaxis(q.reshape(B, NC, CHUNK, H, Dh), 1, 0)
    q_off = jnp.arange(CHUNK)
    k_off = jnp.arange(BAND) - pad
    rel = q_off[:, None] - k_off[None, :]
    idx = jnp.clip(rel, -(CHUNK - 1), MAX_REL) + (CHUNK - 1)
    bias = rel_bias.astype(jnp.float32)[:, idx]
    scale = HEAD_DIM ** -0.5

    def one_chunk(args):
        c, qb = args
        start = c * CHUNK
        kb = lax.dynamic_slice_in_dim(kp, start, BAND, axis=1)
        vb = lax.dynamic_slice_in_dim(vp, start, BAND, axis=1)
        s = jnp.einsum('bqhd,bkhd->bhqk', qb, kb).astype(jnp.float32) * scale + bias
        valid = (k_off + start) >= 0
        s = jnp.where(valid[None, None, None, :], s, NEG_INF)
        pr = jax.nn.softmax(s, axis=-1).astype(vb.dtype)
        return jnp.einsum('bhqk,bkhd->bqhd', pr, vb)

    o = lax.map(one_chunk, (jnp.arange(NC), qc))
    return jnp.moveaxis(o, 0, 1).reshape(B, T, H * Dh)


def causal_dwconv(x, w, b):
    y = lax.conv_general_dilated(
        x, w[:, None, :].astype(x.dtype), window_strides=(1,), padding=[(CONV_W - 1, 0)],
        dimension_numbers=('NWC', 'WIO', 'NWC'), feature_group_count=x.shape[-1])
    return y + b


def conv_glu_ffn(h, w_up, cw, cb, w_down):
    u = h @ w_up
    a, gv = jnp.split(u, 2, axis=-1)
    a = causal_dwconv(a, cw, cb)
    return (jax.nn.gelu(a, approximate=False) * gv) @ w_down


def setup_inputs(seed: int = 0) -> dict:
    key = jax.random.key(seed)
    ks = iter(jax.random.split(key, 40))
    f32 = jnp.float32
    nrm = lambda shape, s: jax.random.normal(next(ks), shape, f32) * s
    ones = lambda shape, s: 1.0 + jax.random.normal(next(ks), shape, f32) * s
    L = DEPTH
    return {
        "x": nrm((BATCH, SEQ, D_MODEL), 1.0),
        "p": nrm((L, BATCH, SEQ, PLE_DIM), 1.0),
        "ln1_g": ones((L, D_MODEL), 0.01),
        "w_in": nrm((L, D_MODEL, IN_COLS), D_MODEL ** -0.5),
        "mix_mu": jax.random.uniform(next(ks), (L, RWKV_COLS), f32, 0.0, 1.0),
        "w0": nrm((L, RWKV_WIDTH), 0.5),
        "w2": nrm((L, DECAY_RANK, RWKV_WIDTH), DECAY_RANK ** -0.5),
        "a0": nrm((L, RWKV_WIDTH), 0.1),
        "a2": nrm((L, ICLR_RANK, RWKV_WIDTH), ICLR_RANK ** -0.5),
        "g2": nrm((L, GATE_RANK, RWKV_WIDTH), GATE_RANK ** -0.5),
        "k_k": ones((L, RWKV_WIDTH), 0.1),
        "k_a": ones((L, RWKV_WIDTH), 0.1),
        "r_k": nrm((L, RWKV_HEADS, HEAD_DIM), 0.1),
        "lnx_w": ones((L, RWKV_WIDTH), 0.01),
        "lnx_b": nrm((L, RWKV_WIDTH), 0.01),
        "rel_bias": nrm((L, ATTN_HEADS, REL_TABLE), 0.1),
        "gate_b": nrm((L, GATE_COLS), 0.01),
        "w_br_rwkv": nrm((L, RWKV_WIDTH, D_MODEL), RWKV_WIDTH ** -0.5),
        "w_br_attn": nrm((L, ATTN_WIDTH, D_MODEL), ATTN_WIDTH ** -0.5),
        "w_o": nrm((L, D_MODEL, D_MODEL), D_MODEL ** -0.5),
        "ln2_g": ones((L, D_MODEL), 0.01),
        "w_ffn_up": nrm((L, D_MODEL, 2 * D_FF), D_MODEL ** -0.5),
        "conv_w": nrm((L, CONV_W, D_FF), CONV_W ** -0.5),
        "conv_b": nrm((L, D_FF), 0.01),
        "w_ffn_down": nrm((L, D_FF, D_MODEL), D_FF ** -0.5),
        "ln3_g": ones((L, D_MODEL), 0.01),
        "w_ple": nrm((L, PLE_DIM, D_MODEL), PLE_DIM ** -0.5),
        "w_pg": nrm((L, D_MODEL, D_MODEL), D_MODEL ** -0.5),
        "b_pg": nrm((L, D_MODEL), 0.01),
        "lnf_g": ones((D_MODEL,), 0.01),
    }


def reference(x, p, ln1_g, w_in, mix_mu, w0, w2, a0, a2, g2, k_k, k_a, r_k, lnx_w, lnx_b,
              rel_bias, gate_b, w_br_rwkv, w_br_attn, w_o, ln2_g, w_ffn_up, conv_w, conv_b,
              w_ffn_down, ln3_g, w_ple, w_pg, b_pg, lnf_g):
    B, T, _ = x.shape
    for i in range(DEPTH):
        h = rms_norm(x, ln1_g[i])
        z = h @ w_in[i]
        z_rwkv, z_q, z_k, z_v, z_gate = jnp.split(
            z, [RWKV_COLS, RWKV_COLS + ATTN_WIDTH, RWKV_COLS + 2 * ATTN_WIDTH,
                RWKV_COLS + ATTN_COLS], axis=-1)
        o_a = rwkv7_time_mix(z_rwkv, mix_mu[i], w0[i], w2[i], a0[i], a2[i], g2[i],
                             k_k[i], k_a[i], r_k[i], lnx_w[i], lnx_b[i])
        heads = lambda t: t.reshape(B, T, ATTN_HEADS, HEAD_DIM)
        o_b = chunk_attention(heads(z_q), heads(z_k), heads(z_v), rel_bias[i])
        gates = jax.nn.sigmoid(z_gate + gate_b[i])
        g_a, g_b = jnp.split(gates, 2, axis=-1)
        merged = g_a * (o_a @ w_br_rwkv[i]) + g_b * (o_b @ w_br_attn[i])
        x = x + merged @ w_o[i]
        h = rms_norm(x, ln2_g[i])
        x = x + conv_glu_ffn(h, w_ffn_up[i], conv_w[i], conv_b[i], w_ffn_down[i])
        h = rms_norm(x, ln3_g[i])
        x = x + (p[i] @ w_ple[i]) * jax.nn.sigmoid(h @ w_pg[i] + b_pg[i])
    return rms_norm(x, lnf_g)
```

```cpp
#include <hip/hip_runtime.h>
#include <hip/hip_cooperative_groups.h>
#include <cstdio>
#include <cstdint>
namespace cg = cooperative_groups;

namespace pg8 {
#define PG8_LAS __attribute__((address_space(3)))
typedef unsigned short bf16_t;
typedef short bf16x8 __attribute__((ext_vector_type(8)));
typedef float f32x4 __attribute__((ext_vector_type(4)));
typedef unsigned u32x4 __attribute__((ext_vector_type(4)));
constexpr int BM = 256, BK = 64, HALF = 128, HTB = HALF * BK * 2  , STAGE_BYTES = 8 * HTB, NXCD = 8, WGM = 8;

__host__ __device__ __forceinline__ int lds_byte(int r, int c) { const int st = (r >> 4) * 2 + (c >> 5), rr = r & 15, cc = c & 31, ob = rr * 64 + cc * 2; return st * 1024 + (ob ^ (((ob >> 9) & 1) << 5)); }
__host__ __device__ __forceinline__ void stage_rc(int b, int& R, int& C) { const int st = b / 1024, sb = b % 1024, swz = sb ^ (((sb >> 9) & 1) << 5); R = (st >> 1) * 16 + swz / 64; C = (st & 1) * 32 + (swz % 64) / 2; }
__host__ __device__ __forceinline__ int perm32(int rho) { const int n = rho >> 4, i = rho & 15; return 8 * (i >> 2) + 4 * n + (i & 3); }

struct Unit { int pm, pn; };
struct Gemm { const bf16_t* A; const bf16_t* Bt; int M, N, K; int lda; int kpairA; };

struct StaticOrder {
    int nM, nN, nwg, G, c;
    __host__ __device__ void init(int M, int N, int G_, int c_) { nM = M / BM; nN = N / BM; nwg = nM * nN; G = G_; c = c_; }
    __host__ __device__ bool next(int i, Unit& u) const {
        const long L = (long)i * G + c; if (L >= nwg) return false;
        int wgid = (int)L; { const int q = nwg / NXCD, r = nwg % NXCD, xcd = wgid % NXCD, off = wgid / NXCD; wgid = (xcd < r ? xcd * (q + 1) : r * (q + 1) + (xcd - r) * q) + off; }
        const int nig = WGM * nN, gid = wgid / nig, fm = gid * WGM, gsz = (nM - fm) < WGM ? (nM - fm) : WGM;
        u.pm = fm + ((wgid % nig) % gsz); u.pn = (wgid % nig) / gsz; return true;
    }
};

__device__ __forceinline__ unsigned cvt_pk_bf16(float lo, float hi) { unsigned r; asm volatile("v_cvt_pk_bf16_f32 %0, %1, %2" : "=v"(r) : "v"(lo), "v"(hi)); return r; }
typedef float f32x2 __attribute__((ext_vector_type(2)));
__device__ __forceinline__ f32x2 gelu_pk(f32x2 v) {
    const f32x2 av = __builtin_elementwise_abs(v), d = av * 0.2316418882f + 1.0f;
    f32x2 t; t.x = __builtin_amdgcn_rcpf(d.x); t.y = __builtin_amdgcn_rcpf(d.y);
    f32x2 q = t * 0.5307027145f + (-0.7265760135f); q = q * t + 0.7107068705f; q = q * t + (-0.142248368f); q = q * t + 0.127414796f; q = q * t;
    const f32x2 s = (v * v) * (-0.72134752044f);
    f32x2 e; e.x = __builtin_amdgcn_exp2f(s.x); e.y = __builtin_amdgcn_exp2f(s.y);
    const f32x2 m = v * (q * e), r = v - m;
    f32x2 o; o.x = v.x < 0.f ? m.x : r.x; o.y = v.y < 0.f ? m.y : r.y; return o;
}

template <class Epi, class Sched, bool ALIGN_EPI>
__device__ __forceinline__ void gemm_phase(PG8_LAS unsigned char* lds, const Gemm g, const Sched& S, const Epi& E, int wid_in, int lane_in) {
    const int wid = __builtin_amdgcn_readfirstlane(wid_in), lane = lane_in, tid = wid * 64 + lane, wr = wid >> 2, wc = wid & 3, fr = lane & 15, fq = lane >> 4;
    const int K = g.K, nt = K / BK;
    unsigned voffA[2], voffB[2];
#pragma unroll
    for (int i = 0; i < 2; ++i) { int R, C; stage_rc(tid * 16 + i * 8192, R, C); const int Rb = (R & ~31) + perm32(R & 31);
        voffA[i] = (unsigned)(R * g.lda + C) * 2u; voffB[i] = (unsigned)(Rb * K + C) * 2u; }
    const size_t kstep = (size_t)(BK * 2);
    const size_t kpairA = (size_t)g.kpairA;
    const size_t hstepA = (size_t)HALF * g.lda * 2, hstepB = (size_t)HALF * K * 2;
    const size_t tstepA = 2 * hstepA, tstepB = 2 * hstepB;
    const unsigned ldsw = (unsigned)wid * 1024u;
    const int aoff = lds_byte(wr * 64 + fr, fq * 8), boff = lds_byte(wc * 32 + fr, fq * 8);
#define PG8_SA(b, h) (((b) * 2 + (h)) * HTB)
#define PG8_SB(b, h) ((4 + (b) * 2 + (h)) * HTB)
#define PG8_STAGE(bufoff, gbase, voff) do { _Pragma("unroll") for (int _i = 0; _i < 2; ++_i) \
        __builtin_amdgcn_global_load_lds((const unsigned*)((const char*)(gbase) + (voff)[_i]), (PG8_LAS unsigned*)(lds + (bufoff) + ldsw + _i * 8192), 16, 0, 0); } while (0)
#define PG8_LDA(dst, b, h) do { _Pragma("unroll") for (int m = 0; m < 4; ++m) _Pragma("unroll") for (int k = 0; k < 2; ++k) dst[m][k] = *(const PG8_LAS bf16x8*)(lds + PG8_SA(b, h) + aoff + m * 2048 + k * 1024); } while (0)
#define PG8_LDB(dst, b, h) do { _Pragma("unroll") for (int n = 0; n < 2; ++n) _Pragma("unroll") for (int k = 0; k < 2; ++k) dst[n][k] = *(const PG8_LAS bf16x8*)(lds + PG8_SB(b, h) + boff + n * 2048 + k * 1024); } while (0)
#define PG8_MMA(ai, bj, At, Bt) do { __builtin_amdgcn_s_setprio(1); _Pragma("unroll") for (int m = 0; m < 4; ++m) _Pragma("unroll") for (int n = 0; n < 2; ++n) _Pragma("unroll") for (int k = 0; k < 2; ++k) \
        acc[ai][bj][m][n] = __builtin_amdgcn_mfma_f32_16x16x32_bf16(Bt[n][k], At[m][k], acc[ai][bj][m][n], 0, 0, 0); __builtin_amdgcn_s_setprio(0); } while (0)
#define PG8_WAIT_V(n) asm volatile("s_waitcnt vmcnt(" #n ")" ::: "memory")
#define PG8_WAIT_L(n) asm volatile("s_waitcnt lgkmcnt(" #n ")" ::: "memory")
#define PG8_BAR __builtin_amdgcn_s_barrier()
#define PG8_SCHED __builtin_amdgcn_sched_barrier(0)
    Unit cur, nxt; int ui = 0;
    if (!S.next(0, cur)) return;
    f32x4 acc[2][2][4][2];
#pragma unroll
    for (int a = 0; a < 2; ++a)
#pragma unroll
        for (int b = 0; b < 2; ++b)
#pragma unroll
            for (int m = 0; m < 4; ++m)
#pragma unroll
                for (int n = 0; n < 2; ++n) acc[a][b][m][n] = (f32x4){0.f, 0.f, 0.f, 0.f};
    bf16x8 At[4][2], B0[2][2], B1[2][2];
    const char* cA = (const char*)g.A + (size_t)cur.pm * tstepA; const char* cB = (const char*)g.Bt + (size_t)cur.pn * tstepB;
    PG8_STAGE(PG8_SB(0, 0), cB, voffB); PG8_STAGE(PG8_SB(0, 1), cB + hstepB, voffB); PG8_STAGE(PG8_SA(0, 0), cA, voffA); PG8_STAGE(PG8_SA(0, 1), cA + hstepA, voffA);
    if (wr == 1) PG8_BAR;
    PG8_WAIT_V(2); PG8_BAR;
    PG8_STAGE(PG8_SB(1, 0), cB + kstep, voffB); PG8_STAGE(PG8_SA(1, 0), cA + kstep, voffA); PG8_STAGE(PG8_SB(1, 1), cB + hstepB + kstep, voffB);
    PG8_WAIT_V(6); PG8_BAR;
    for (;;) {
        const bool has_next = S.next(ui + 1, nxt);
        const char* nA = has_next ? (const char*)g.A + (size_t)nxt.pm * tstepA : cA; const char* nB = has_next ? (const char*)g.Bt + (size_t)nxt.pn * tstepB : cB;
#pragma unroll 1
        for (int t = 0; t < nt; t += 2) {
            if constexpr (Epi::MID) { if (t == (nt >> 1)) E.mid(acc, cur, wr, wc, fr, fq); }
            const bool last = (t == nt - 2);
            const char* a1 = cA + (size_t)(t >> 1) * kpairA + kstep;
            const char* a2 = last ? nA : cA + (size_t)((t >> 1) + 1) * kpairA; const char* b2 = last ? nB : cB + (size_t)(t + 2) * kstep;
            const char* a3 = a2 + kstep; const char* b3 = b2 + kstep;
            PG8_LDB(B0, 0, 0); PG8_LDB(B1, 0, 1); PG8_SCHED; PG8_LDA(At, 0, 0); PG8_STAGE(PG8_SA(1, 1), a1 + hstepA, voffA);
            PG8_WAIT_V(8); PG8_WAIT_L(0); PG8_BAR; PG8_MMA(0, 0, At, B0); PG8_MMA(0, 1, At, B1); PG8_BAR; PG8_SCHED;
            PG8_LDA(At, 0, 1); PG8_STAGE(PG8_SB(0, 0), b2, voffB); PG8_STAGE(PG8_SB(0, 1), b2 + hstepB, voffB); PG8_STAGE(PG8_SA(0, 0), a2, voffA);
            PG8_WAIT_V(8); PG8_WAIT_L(0); PG8_BAR; PG8_MMA(1, 0, At, B0); PG8_MMA(1, 1, At, B1); PG8_BAR; PG8_SCHED;
            PG8_LDB(B0, 1, 0); PG8_LDB(B1, 1, 1); PG8_SCHED; PG8_LDA(At, 1, 0); PG8_STAGE(PG8_SA(0, 1), a2 + hstepA, voffA);
            PG8_WAIT_V(8); PG8_WAIT_L(0); PG8_BAR; PG8_MMA(0, 0, At, B0); PG8_MMA(0, 1, At, B1); PG8_BAR; PG8_SCHED;
            PG8_LDA(At, 1, 1); PG8_STAGE(PG8_SB(1, 0), b3, voffB); PG8_STAGE(PG8_SB(1, 1), b3 + hstepB, voffB); PG8_STAGE(PG8_SA(1, 0), a3, voffA);
            PG8_WAIT_V(8); PG8_WAIT_L(0); PG8_BAR; PG8_MMA(1, 0, At, B0); PG8_MMA(1, 1, At, B1); PG8_BAR; PG8_SCHED;
        }
        if constexpr (ALIGN_EPI) { if (wr == 0) PG8_BAR; }
        E(acc, cur, wr, wc, fr, fq);
        if (!has_next) break;
#pragma unroll
        for (int a = 0; a < 2; ++a)
#pragma unroll
            for (int b = 0; b < 2; ++b)
#pragma unroll
                for (int m = 0; m < 4; ++m)
#pragma unroll
                    for (int n = 0; n < 2; ++n) acc[a][b][m][n] = (f32x4){0.f, 0.f, 0.f, 0.f};
        cur = nxt; cA = nA; cB = nB; ++ui;
        if constexpr (ALIGN_EPI) { if (wr == 1) PG8_BAR; }
    }
    PG8_WAIT_V(0);
    if constexpr (!ALIGN_EPI) { if (wr == 0) PG8_BAR; }
    PG8_BAR;
#undef PG8_SA
#undef PG8_SB
#undef PG8_STAGE
#undef PG8_LDA
#undef PG8_LDB
#undef PG8_MMA
#undef PG8_WAIT_V
#undef PG8_WAIT_L
#undef PG8_BAR
#undef PG8_SCHED
}
}

typedef unsigned short bf16;
typedef short bf16x8 __attribute__((ext_vector_type(8)));
typedef float f32x4 __attribute__((ext_vector_type(4)));
typedef float f32x16 __attribute__((ext_vector_type(16)));
typedef float f32x2 __attribute__((ext_vector_type(2)));
typedef __bf16 bf16x2v __attribute__((ext_vector_type(2)));
typedef unsigned u32x4 __attribute__((ext_vector_type(4)));
typedef unsigned u32x2 __attribute__((ext_vector_type(2)));
typedef _Float16 h4 __attribute__((ext_vector_type(4)));

constexpr int NB = 8, T = 4096, D = 1024, M = NB * T, NH = 8;
constexpr int ZMAIN = 3328, NGATE = 2048, DFF = 2816, NUP = 5632, PLED = 256;
constexpr float NORM_EPS = 1e-6f, GN_EPS = 64e-5f, LOG2E = 1.4426950408889634f, QSCALE = 0.125f * 1.4426950408889634f;
constexpr int NWAVES = 8, NTHR = 512;
constexpr int LDS_BYTES = 147456;
constexpr int REC = 896;

constexpr size_t MiB = (size_t)1 << 20;
constexpr size_t WS_SS2 = 0, WS_SS3 = 128 * 1024, WS_SSF = 256 * 1024, WS_BAR = 512 * 1024, WS_BT2 = 1 * MiB, CTL_BYTES = 2 * MiB;
constexpr size_t WS_WIN = 2 * MiB, WS_WUP = 13 * MiB, WS_WDOWN = 24 * MiB, WS_WO = 30 * MiB, WS_WBR = 32 * MiB, WS_WPG = 34 * MiB, WS_WPLE = 36 * MiB;
constexpr size_t WS_PB = 37 * MiB, WS_XB = 53 * MiB;
constexpr size_t WS_ZRM = 117 * MiB, WS_OAB = 117 * MiB, WS_U = 117 * MiB, WS_PL = 117 * MiB;
constexpr size_t WS_QK = 213 * MiB, WS_GATES = 213 * MiB, WS_MERGED = 341 * MiB;
constexpr size_t WS_PACK = 277 * MiB, WS_V = 277 * MiB, WS_ZLOW = 309 * MiB;
constexpr size_t WS_BONUS = 501 * MiB, WS_END = 512 * MiB;
constexpr size_t O_A = 0, O_G = 32 * MiB, O_VT = 64 * MiB, O_Y = 96 * MiB, O_A2 = 96 * MiB;

__device__ __forceinline__ unsigned f2bf(float f) { unsigned u = __builtin_bit_cast(unsigned, f); return (u + 0x7fffu + ((u >> 16) & 1u)) >> 16; }
__device__ __forceinline__ unsigned pk2(float lo, float hi) { return f2bf(lo) | (f2bf(hi) << 16); }
__device__ __forceinline__ float bf2f(unsigned b) { return __builtin_bit_cast(float, b << 16); }
__device__ __forceinline__ float bflo(unsigned w) { return __builtin_bit_cast(float, w << 16); }
__device__ __forceinline__ float bfhi(unsigned w) { return __builtin_bit_cast(float, w & 0xffff0000u); }
__device__ __forceinline__ unsigned cvtpk(float lo, float hi) { f32x2 v = {lo, hi}; bf16x2v b = __builtin_convertvector(v, bf16x2v); return __builtin_bit_cast(unsigned, b); }
__device__ __forceinline__ unsigned short f2h(float f) { _Float16 h = (_Float16)f; return __builtin_bit_cast(unsigned short, h); }
__device__ __forceinline__ float wave_sum(float v) {
#pragma unroll
    for (int o = 1; o < 64; o <<= 1) v += __shfl_xor(v, o);
    return v;
}
__device__ __forceinline__ float sigmoidf_(float x) { return 1.f / (1.f + __expf(-x)); }
template <int CTRL> __device__ __forceinline__ float dpp_add(float x) { return x + __builtin_bit_cast(float, __builtin_amdgcn_update_dpp(0, __builtin_bit_cast(int, x), CTRL, 0xF, 0xF, true)); }
__device__ __forceinline__ float allreduce16(float x) { x = dpp_add<0xB1>(x); x = dpp_add<0x4E>(x); x = dpp_add<0x141>(x); x = dpp_add<0x140>(x); return x; }
#define MFMA32(a, b, c) __builtin_amdgcn_mfma_f32_32x32x16_bf16((a), (b), (c), 0, 0, 0)
__device__ __forceinline__ bf16x8 packstep(const f32x16& x, int s) {
    u32x4 w; w[0] = cvtpk(x[8 * s], x[8 * s + 1]); w[1] = cvtpk(x[8 * s + 2], x[8 * s + 3]); w[2] = cvtpk(x[8 * s + 4], x[8 * s + 5]); w[3] = cvtpk(x[8 * s + 6], x[8 * s + 7]);
    return __builtin_bit_cast(bf16x8, w);
}

using pg8::Unit; using pg8::cvt_pk_bf16;
#define EPI_TRAITS(mid) static constexpr bool PERM = true, AFTER_DRAIN = false, MID = mid;
#define EPI_ARGS const f32x4 (&acc)[2][2][4][2], const Unit& u, int wr, int wc, int fr, int fq
__device__ __forceinline__ u32x4 pack8(f32x4 v0, f32x4 v1) { u32x4 w; w.x = cvt_pk_bf16(v0[0], v0[1]); w.y = cvt_pk_bf16(v0[2], v0[3]); w.z = cvt_pk_bf16(v1[0], v1[1]); w.w = cvt_pk_bf16(v1[2], v1[3]); return w; }
__device__ __forceinline__ void unpack8(u32x4 w, f32x4& v0, f32x4& v1) { v0 = (f32x4){bflo(w.x), bfhi(w.x), bflo(w.y), bfhi(w.y)}; v1 = (f32x4){bflo(w.z), bfhi(w.z), bflo(w.w), bfhi(w.w)}; }

struct EpiZ { EPI_TRAITS(false)
    bf16 *ZRM, *ZLOW, *QK, *V;
    __device__ __forceinline__ void operator()(EPI_ARGS) const {
        const int colt = u.pn * 256; bf16* base; int ldc, c0; float sc = 1.f;
        if (colt < 1536) { base = ZRM; ldc = 1536; c0 = colt; }
        else if (colt < 1792) { base = ZLOW; ldc = 256; c0 = 0; }
        else if (colt < 2816) { base = QK; ldc = 1024; c0 = colt - 1792; if (c0 < 512) sc = QSCALE; }
        else { base = V; ldc = 512; c0 = colt - 2816; }
        const int col0 = c0 + wc * 32 + 8 * fq, row0 = u.pm * 256 + wr * 64 + fr;
#pragma unroll
        for (int ai = 0; ai < 2; ++ai)
#pragma unroll
            for (int m = 0; m < 4; ++m) { bf16* rowp = base + (size_t)(row0 + ai * 128 + m * 16) * ldc + col0;
#pragma unroll
                for (int bj = 0; bj < 2; ++bj) *(u32x4*)(rowp + bj * 128) = pack8(acc[ai][bj][m][0] * sc, acc[ai][bj][m][1] * sc); }
    }
};
struct EpiPlain { EPI_TRAITS(false)
    bf16* O; int ldc;
    __device__ __forceinline__ void operator()(EPI_ARGS) const {
        const int col0 = u.pn * 256 + wc * 32 + 8 * fq, row0 = u.pm * 256 + wr * 64 + fr;
#pragma unroll
        for (int ai = 0; ai < 2; ++ai)
#pragma unroll
            for (int m = 0; m < 4; ++m) { bf16* rowp = O + (size_t)(row0 + ai * 128 + m * 16) * ldc + col0;
#pragma unroll
                for (int bj = 0; bj < 2; ++bj) *(u32x4*)(rowp + bj * 128) = pack8(acc[ai][bj][m][0], acc[ai][bj][m][1]); }
    }
};
struct EpiLR { EPI_TRAITS(false)
    unsigned char* PACK; bf16* Aout; bf16* Gout; const float* w0; const float* a0;
    __device__ __forceinline__ void operator()(EPI_ARGS) const {
        const int colt = u.pn * 256, region = colt >> 9; const int row0 = u.pm * 256 + wr * 64 + fr;
#pragma unroll
        for (int bj = 0; bj < 2; ++bj) {
            const int c = (colt & 511) + bj * 128 + wc * 32 + 8 * fq;
            f32x4 p0 = {0.f, 0.f, 0.f, 0.f}, p1 = p0;
            if (region == 0) { p0 = *(const f32x4*)(w0 + c); p1 = *(const f32x4*)(w0 + c + 4); }
            else if (region == 1) { p0 = *(const f32x4*)(a0 + c); p1 = *(const f32x4*)(a0 + c + 4); }
#pragma unroll
            for (int ai = 0; ai < 2; ++ai)
#pragma unroll
                for (int m = 0; m < 4; ++m) {
                    const int row = row0 + ai * 128 + m * 16;
                    f32x4 v0 = acc[ai][bj][m][0] + p0, v1 = acc[ai][bj][m][1] + p1;
                    if (region == 0) {
#pragma unroll
                        for (int e = 0; e < 4; ++e) { v0[e] = __expf(-0.6065306597126334f * sigmoidf_(v0[e])); v1[e] = __expf(-0.6065306597126334f * sigmoidf_(v1[e])); }
                        const int b = row / T, t = row % T, h = c >> 6;
                        float* dst = (float*)(PACK + ((size_t)((b * NH + h) * T + t)) * REC + 640) + (c & 63);
                        *(f32x4*)dst = v0; *(f32x4*)(dst + 4) = v1;
                    } else if (region == 1) {
#pragma unroll
                        for (int e = 0; e < 4; ++e) { v0[e] = sigmoidf_(v0[e]); v1[e] = sigmoidf_(v1[e]); }
                        *(u32x4*)(Aout + (size_t)row * 512 + c) = pack8(v0, v1);
                    } else {
                        *(u32x4*)(Gout + (size_t)row * 512 + c) = pack8(v0, v1);
                    }
                }
        }
    }
};
struct EpiGate { EPI_TRAITS(false)
    bf16* O; const float* bias;
    __device__ __forceinline__ void operator()(EPI_ARGS) const {
        const int col0 = u.pn * 256 + wc * 32 + 8 * fq, row0 = u.pm * 256 + wr * 64 + fr;
#pragma unroll
        for (int bj = 0; bj < 2; ++bj) {
            const f32x4 b0 = *(const f32x4*)(bias + col0 + bj * 128), b1 = *(const f32x4*)(bias + col0 + bj * 128 + 4);
#pragma unroll
            for (int ai = 0; ai < 2; ++ai)
#pragma unroll
                for (int m = 0; m < 4; ++m) {
                    f32x4 v0 = acc[ai][bj][m][0] + b0, v1 = acc[ai][bj][m][1] + b1;
#pragma unroll
                    for (int e = 0; e < 4; ++e) { v0[e] = sigmoidf_(v0[e]); v1[e] = sigmoidf_(v1[e]); }
                    *(u32x4*)(O + (size_t)(row0 + ai * 128 + m * 16) * NGATE + col0 + bj * 128) = pack8(v0, v1);
                }
        }
    }
};
struct EpiMerge { EPI_TRAITS(true)
    const bf16* GATES; bf16* O;
    __device__ __forceinline__ void mid(f32x4 (&acc)[2][2][4][2], const Unit& u, int wr, int wc, int fr, int fq) const {
        const int col0 = u.pn * 256 + wc * 32 + 8 * fq, row0 = u.pm * 256 + wr * 64 + fr;
#pragma unroll
        for (int ai = 0; ai < 2; ++ai)
#pragma unroll
            for (int m = 0; m < 4; ++m)
#pragma unroll
                for (int bj = 0; bj < 2; ++bj)
#pragma unroll
                    for (int n = 0; n < 2; ++n) {
                        int row_ = row0 + ai * 128 + m * 16; asm volatile("" : "+v"(row_));
                        const bf16* gp = GATES + (size_t)row_ * NGATE + col0 + bj * 128 + 4 * n;
                        const u32x2 ga = *(const u32x2*)gp, gb = *(const u32x2*)(gp + 1024);
                        const float a_[4] = {bflo(ga.x), bfhi(ga.x), bflo(ga.y), bfhi(ga.y)}, b_[4] = {bflo(gb.x), bfhi(gb.x), bflo(gb.y), bfhi(gb.y)};
#pragma unroll
                        for (int e = 0; e < 4; ++e) acc[ai][bj][m][n][e] *= a_[e] * __builtin_amdgcn_rcpf(fmaxf(b_[e], 1e-30f));
                        if (bj == 1 && n == 1) __builtin_amdgcn_sched_barrier(0);
                    }
    }
    __device__ __forceinline__ void operator()(EPI_ARGS) const {
        const int col0 = u.pn * 256 + wc * 32 + 8 * fq, row0 = u.pm * 256 + wr * 64 + fr;
#pragma unroll
        for (int ai = 0; ai < 2; ++ai)
#pragma unroll
            for (int m = 0; m < 4; ++m)
#pragma unroll
                for (int bj = 0; bj < 2; ++bj) {
                    int row_ = row0 + ai * 128 + m * 16; asm volatile("" : "+v"(row_)); const size_t row = (size_t)row_;
                    f32x4 b0, b1; unpack8(*(const u32x4*)(GATES + row * NGATE + 1024 + col0 + bj * 128), b0, b1);
#pragma unroll
                    for (int e = 0; e < 4; ++e) { b0[e] = fmaxf(b0[e], 1e-30f); b1[e] = fmaxf(b1[e], 1e-30f); }
                    *(u32x4*)(O + row * D + col0 + bj * 128) = pack8(acc[ai][bj][m][0] * b0, acc[ai][bj][m][1] * b1);
                    if (bj == 1 && (m & 1)) __builtin_amdgcn_sched_barrier(0);
                }
    }
};
struct EpiRes { EPI_TRAITS(false)
    const float* base; float* out; bf16* XB; float* SS; int dost;
    __device__ __forceinline__ void operator()(EPI_ARGS) const {
        const int col0 = u.pn * 256 + wc * 32 + 8 * fq, row0 = u.pm * 256 + wr * 64 + fr;
#pragma unroll
        for (int ai = 0; ai < 2; ++ai)
#pragma unroll
            for (int m = 0; m < 4; ++m) {
                const size_t row = (size_t)(row0 + ai * 128 + m * 16); float ss = 0.f;
#pragma unroll
                for (int bj = 0; bj < 2; ++bj) {
                    const size_t o = row * D + col0 + bj * 128;
                    f32x4 v0 = *(const f32x4*)(base + o) + acc[ai][bj][m][0], v1 = *(const f32x4*)(base + o + 4) + acc[ai][bj][m][1];
                    if (dost) { *(f32x4*)(out + o) = v0; *(f32x4*)(out + o + 4) = v1; *(u32x4*)(XB + o) = pack8(v0, v1); }
#pragma unroll
                    for (int e = 0; e < 4; ++e) ss += v0[e] * v0[e] + v1[e] * v1[e];
                }
                ss += __shfl_xor(ss, 16); ss += __shfl_xor(ss, 32);
                if (fq == 0 && dost) atomicAdd(SS + row, ss);
            }
    }
};
struct EpiUp { EPI_TRAITS(false)
    bf16* O; const float* SS;
    __device__ __forceinline__ void operator()(EPI_ARGS) const {
        const int col0 = u.pn * 256 + wc * 32 + 8 * fq, row0 = u.pm * 256 + wr * 64 + fr;
#pragma unroll
        for (int ai = 0; ai < 2; ++ai)
#pragma unroll
            for (int m = 0; m < 4; ++m) {
                const size_t row = (size_t)(row0 + ai * 128 + m * 16); const float rs = rsqrtf(SS[row] * (1.f / D) + NORM_EPS);
#pragma unroll
                for (int bj = 0; bj < 2; ++bj) *(u32x4*)(O + row * NUP + col0 + bj * 128) = pack8(acc[ai][bj][m][0] * rs, acc[ai][bj][m][1] * rs);
            }
    }
};
template <int CTRL> __device__ __forceinline__ float dpp_mov_f(float oldv, float x) { return __builtin_bit_cast(float, __builtin_amdgcn_update_dpp(__builtin_bit_cast(int, oldv), __builtin_bit_cast(int, x), CTRL, 0xF, 0xF, false)); }
struct EpiUpAct { EPI_TRAITS(false)
    bf16* O; const float* SS; const float* cw; const float* cb;
    __device__ __forceinline__ void operator()(EPI_ARGS) const {
        const int colb = u.pn * 256 + wc * 32 + 8 * fq, ch0 = u.pn * 128 + wc * 32 + 8 * fq, row0 = u.pm * 256 + wr * 64 + fr;
        f32x4 W0[2], W1[2], W2[2], CB[2];
#pragma unroll
        for (int n = 0; n < 2; ++n) { W0[n] = *(const f32x4*)(cw + ch0 + 4 * n); W1[n] = *(const f32x4*)(cw + DFF + ch0 + 4 * n); W2[n] = *(const f32x4*)(cw + 2 * DFF + ch0 + 4 * n); CB[n] = *(const f32x4*)(cb + ch0 + 4 * n); }
#pragma unroll
        for (int ai = 0; ai < 2; ++ai) {
            f32x4 pv[2] = {{0.f, 0.f, 0.f, 0.f}, {0.f, 0.f, 0.f, 0.f}};
#pragma unroll
            for (int m = 0; m < 4; ++m) {
                int row_ = row0 + ai * 128 + m * 16; asm volatile("" : "+v"(row_)); const size_t row = (size_t)row_;
                const float rs = rsqrtf(SS[row] * (1.f / D) + NORM_EPS);
                f32x4 cur[2] = {acc[ai][0][m][0] * rs, acc[ai][0][m][1] * rs}, gv[2] = {acc[ai][1][m][0] * rs, acc[ai][1][m][1] * rs}, r[2];
#pragma unroll
                for (int n = 0; n < 2; ++n)
#pragma unroll
                    for (int e = 0; e < 4; e += 2) {
                        f32x2 cv;
                        { const float c_ = cur[n][e], p_ = pv[n][e]; const float p1 = dpp_mov_f<0x111>(dpp_mov_f<0x121>(0.f, p_), c_), p2 = dpp_mov_f<0x112>(dpp_mov_f<0x122>(0.f, p_), c_);
                          cv.x = CB[n][e] + W0[n][e] * p2 + W1[n][e] * p1 + W2[n][e] * c_; }
                        { const float c_ = cur[n][e + 1], p_ = pv[n][e + 1]; const float p1 = dpp_mov_f<0x111>(dpp_mov_f<0x121>(0.f, p_), c_), p2 = dpp_mov_f<0x112>(dpp_mov_f<0x122>(0.f, p_), c_);
                          cv.y = CB[n][e + 1] + W0[n][e + 1] * p2 + W1[n][e + 1] * p1 + W2[n][e + 1] * c_; }
                        const f32x2 ge = pg8::gelu_pk(cv); r[n][e] = ge.x * gv[n][e]; r[n][e + 1] = ge.y * gv[n][e + 1];
                    }
                const bool rawrow = (m == 0) && (fr < 2);
                if ((m == 0 && fr < 2) || (m == 3 && fr >= 14)) *(u32x4*)(O + row * NUP + colb) = pack8(cur[0], cur[1]);
                *(u32x4*)(O + row * NUP + colb + 128) = rawrow ? pack8(gv[0], gv[1]) : pack8(r[0], r[1]);
                pv[0] = cur[0]; pv[1] = cur[1];
                __builtin_amdgcn_sched_barrier(0);
            }
        }
    }
};
struct EpiFinal { EPI_TRAITS(false)
    float* out; const bf16* PL; const float* SS3; const float* bias; float* SSF; int dost;
    __device__ __forceinline__ void operator()(EPI_ARGS) const {
        const int col0 = u.pn * 256 + wc * 32 + 8 * fq, row0 = u.pm * 256 + wr * 64 + fr;
        f32x4 bb[2][2];
#pragma unroll
        for (int bj = 0; bj < 2; ++bj) { bb[bj][0] = *(const f32x4*)(bias + col0 + bj * 128); bb[bj][1] = *(const f32x4*)(bias + col0 + bj * 128 + 4); }
#pragma unroll
        for (int ai = 0; ai < 2; ++ai)
#pragma unroll
            for (int m = 0; m < 4; ++m) {
                const size_t row = (size_t)(row0 + ai * 128 + m * 16); const float rs = rsqrtf(SS3[row] * (1.f / D) + NORM_EPS); float ss = 0.f;
#pragma unroll
                for (int bj = 0; bj < 2; ++bj) {
                    const size_t o = row * D + col0 + bj * 128;
                    f32x4 p0, p1; unpack8(*(const u32x4*)(PL + o), p0, p1);
                    f32x4 g0 = acc[ai][bj][m][0] * rs + bb[bj][0], g1 = acc[ai][bj][m][1] * rs + bb[bj][1];
#pragma unroll
                    for (int e = 0; e < 4; ++e) { g0[e] = sigmoidf_(g0[e]); g1[e] = sigmoidf_(g1[e]); }
                    f32x4 v0 = *(const f32x4*)(out + o) + p0 * g0, v1 = *(const f32x4*)(out + o + 4) + p1 * g1;
                    if (dost) { *(f32x4*)(out + o) = v0; *(f32x4*)(out + o + 4) = v1; }
#pragma unroll
                    for (int e = 0; e < 4; ++e) ss += v0[e] * v0[e] + v1[e] * v1[e];
                }
                ss += __shfl_xor(ss, 16); ss += __shfl_xor(ss, 32);
                if (fq == 0 && dost) atomicAdd(SSF + row, ss);
            }
    }
};

#define XB_TMO      128
#define XB_XCNT(j)  (256  + 64 * (j))
#define XB_XSUB(j)  (1280 + 64 * (j))
#define XB_XGEN(j)  (2304 + 64 * (j))
#define XB_TOP      3328
#define XB_TOPGEN   3392
#define XCD_BAR_WORDS 3456
#define XB_SPIN_CAP (1u << 18)

__device__ __forceinline__ unsigned xb_ld(unsigned* p)              { return __hip_atomic_load(p, __ATOMIC_RELAXED, __HIP_MEMORY_SCOPE_AGENT); }
__device__ __forceinline__ unsigned xb_add(unsigned* p, unsigned v) { return __hip_atomic_fetch_add(p, v, __ATOMIC_RELAXED, __HIP_MEMORY_SCOPE_AGENT); }
__device__ __forceinline__ unsigned xb_xcc_id() { return (unsigned)__builtin_amdgcn_s_getreg((3 << 11) | 20) & 0xFu; }
#define XB_SPIN(cond, bar) do { unsigned _sp = 0; while (cond) { __builtin_amdgcn_s_sleep(1); \
    if ((++_sp & 255u) == 0u) { if (xb_ld(&(bar)[XB_TMO])) break; if (_sp > XB_SPIN_CAP) { atomicAdd(&(bar)[XB_TMO], 1u); break; } } } } while (0)

struct XcdBarrier {
    unsigned* bar; unsigned x;
    volatile __attribute__((address_space(3))) unsigned* st;
};

__device__ __forceinline__ XcdBarrier xcd_barrier_post(unsigned* bar, volatile __attribute__((address_space(3))) unsigned* st) {
    XcdBarrier b; b.bar = bar; b.x = xb_xcc_id(); b.st = st;
    if (threadIdx.x == 0) (void)xb_add(&bar[XB_XCNT(b.x)], 1u);
    return b;
}
__device__ __forceinline__ void xcd_barrier_complete(unsigned* bar, unsigned x, unsigned& nloc, unsigned& nx) {
    const unsigned G = gridDim.x * gridDim.y * gridDim.z;
    unsigned sum, cnt, mine, sp = 0u;
    for (;;) {
        sum = 0u; cnt = 0u; mine = 0u;
#pragma unroll
        for (unsigned j = 0; j < 16; ++j) { const unsigned c = xb_ld(&bar[XB_XCNT(j)]); sum += c; cnt += (c > 0u) ? 1u : 0u; mine = (j == x) ? c : mine; }
        if (sum == G) break;
        __builtin_amdgcn_s_sleep(1);
        if ((++sp & 255u) == 0u) { if (xb_ld(&bar[XB_TMO])) break; if (sp > XB_SPIN_CAP) { atomicAdd(&bar[XB_TMO], 1u); break; } }
    }
    nloc = mine > 0u ? mine : 1u; nx = cnt > 0u ? cnt : 1u;
}

__device__ __forceinline__ void xcd_barrier(const XcdBarrier& b, int tid_) {
    asm volatile("s_waitcnt vmcnt(0)" ::: "memory");
    __syncthreads();
    if (tid_ == 0) {
        unsigned* bar = b.bar;
        __builtin_amdgcn_s_waitcnt(0);
        unsigned nloc = b.st[0], nx = b.st[1];
        if (nloc == 0u) { xcd_barrier_complete(bar, b.x, nloc, nx); b.st[0] = nloc; b.st[1] = nx; }
        const unsigned old = xb_add(&bar[XB_XSUB(b.x)], 1u);
        const unsigned gen = old / nloc;
        if (old + 1u == (gen + 1u) * nloc) {
            __builtin_amdgcn_fence(__ATOMIC_RELEASE, "agent");
            asm volatile("s_waitcnt vmcnt(0)" ::: "memory");
            const unsigned og = xb_add(&bar[XB_TOP], 1u);
            const unsigned tg = og / nx;
            if (og + 1u == (tg + 1u) * nx) xb_add(&bar[XB_TOPGEN], 1u);
            else XB_SPIN(xb_ld(&bar[XB_TOPGEN]) == tg, bar);
            __builtin_amdgcn_fence(__ATOMIC_ACQUIRE, "agent");
            xb_add(&bar[XB_XGEN(b.x)], 1u);
            asm volatile("s_waitcnt vmcnt(0)" ::: "memory");
        } else {
            XB_SPIN(xb_ld(&bar[XB_XGEN(b.x)]) == gen, bar);
            __builtin_amdgcn_fence(__ATOMIC_ACQUIRE, "agent");
            asm volatile("s_waitcnt vmcnt(0)" ::: "memory");
        }
    }
    __syncthreads();
}

struct Ctx { unsigned char* lds; int tid, lane, wave, G, gw, NGW; };
__device__ __forceinline__ int vlane_id() { int l; asm volatile("v_mbcnt_lo_u32_b32 %0, -1, 0\n\tv_mbcnt_hi_u32_b32 %0, -1, %0" : "=v"(l)); return l; }

__device__ __forceinline__ void p0_transpose_item(const float* W, int K, int N, bf16* WT, int ldk, int koff, int row_off, bool upperm, const float* gain, float* scr, int item, int lane) {
    const int nblk = N / 32, kb = item / nblk, nb = item % nblk, k0 = 64 * kb, n0 = 32 * nb;
#pragma unroll 16
    for (int i = 0; i < 32; ++i) { const int kk = 2 * i + (lane >> 5); float v = W[(size_t)(k0 + kk) * N + n0 + (lane & 31)]; if (gain) v *= gain[k0 + kk]; scr[kk * 33 + (lane & 31)] = v; }
    asm volatile("s_waitcnt lgkmcnt(0)" ::: "memory");
    const int c = lane & 7;
#pragma unroll
    for (int j = 0; j < 4; ++j) { const int n = (lane >> 3) + 8 * j; const float* s = scr + (8 * c) * 33 + n;
        u32x4 o; o.x = pk2(s[0 * 33], s[1 * 33]); o.y = pk2(s[2 * 33], s[3 * 33]); o.z = pk2(s[4 * 33], s[5 * 33]); o.w = pk2(s[6 * 33], s[7 * 33]);
        const int ncol = n0 + n; int drow = row_off + ncol;
        if (upperm) { const int half = ncol >= DFF ? 1 : 0, ch = ncol - half * DFF; drow = 256 * (ch >> 7) + 128 * half + (ch & 127); }
        *(u32x4*)(WT + (size_t)drow * ldk + koff + k0 + 8 * c) = o; }
    asm volatile("s_waitcnt lgkmcnt(0)" ::: "memory");
}

struct P { const float* in[30]; float* out; unsigned char* ws; int ph_lo, ph_hi; };
enum { I_X = 0, I_P, I_LN1, I_WIN, I_MU, I_W0, I_W2, I_A0, I_A2, I_G2, I_KK, I_KA, I_RK, I_LNXW, I_LNXB, I_REL, I_GATEB, I_WBRR, I_WBRA, I_WO, I_LN2, I_WUP, I_CONVW, I_CONVB, I_WDOWN, I_LN3, I_WPLE, I_WPG, I_BPG, I_LNF };

__device__ __forceinline__ void phase0(const P& p, const Ctx& c) {
    float* scr = (float*)(c.lds + c.wave * 16384);
    unsigned char* ws = p.ws;
    constexpr int I1 = 16 * 168, I2 = 16 * 176, I3 = 44 * 32, I4 = 16 * 32, I5 = 8 * 32, I6 = 8 * 32, I7 = 16 * 32, I8 = 4 * 32, I9 = 16, I10 = 16, I11 = 32;
    constexpr int NITEMS = I1 + I2 + I3 + I4 + I5 + I6 + I7 + I8 + I9 + I10 + I11;
    for (int it = c.gw; it < NITEMS; it += c.NGW) {
        int r = it;
        if (r < I1) { p0_transpose_item(p.in[I_WIN], D, 5376, (bf16*)(ws + WS_WIN), D, 0, 0, false, p.in[I_LN1], scr, r, c.lane); continue; } r -= I1;
        if (r < I2) { p0_transpose_item(p.in[I_WUP], D, NUP, (bf16*)(ws + WS_WUP), D, 0, 0, true, p.in[I_LN2], scr, r, c.lane); continue; } r -= I2;
        if (r < I3) { p0_transpose_item(p.in[I_WDOWN], DFF, D, (bf16*)(ws + WS_WDOWN), DFF, 0, 0, false, nullptr, scr, r, c.lane); continue; } r -= I3;
        if (r < I4) { p0_transpose_item(p.in[I_WO], D, D, (bf16*)(ws + WS_WO), D, 0, 0, false, nullptr, scr, r, c.lane); continue; } r -= I4;
        if (r < I5) { p0_transpose_item(p.in[I_WBRR], 512, D, (bf16*)(ws + WS_WBR), D, 0, 0, false, nullptr, scr, r, c.lane); continue; } r -= I5;
        if (r < I6) { p0_transpose_item(p.in[I_WBRA], 512, D, (bf16*)(ws + WS_WBR), D, 512, 0, false, nullptr, scr, r, c.lane); continue; } r -= I6;
        if (r < I7) { p0_transpose_item(p.in[I_WPG], D, D, (bf16*)(ws + WS_WPG), D, 0, 0, false, p.in[I_LN3], scr, r, c.lane); continue; } r -= I7;
        if (r < I8) { p0_transpose_item(p.in[I_WPLE], PLED, D, (bf16*)(ws + WS_WPLE), PLED, 0, 0, false, nullptr, scr, r, c.lane); continue; } r -= I8;
        if (r < I9) { p0_transpose_item(p.in[I_W2], 64, 512, (bf16*)(ws + WS_BT2), 256, 0, 0, false, nullptr, scr, r, c.lane); continue; } r -= I9;
        if (r < I10) { p0_transpose_item(p.in[I_A2], 64, 512, (bf16*)(ws + WS_BT2), 256, 64, 512, false, nullptr, scr, r, c.lane); continue; } r -= I10;
        p0_transpose_item(p.in[I_G2], 128, 512, (bf16*)(ws + WS_BT2), 256, 128, 1024, false, nullptr, scr, r, c.lane);
    }
    const float* x = p.in[I_X]; bf16* H1 = (bf16*)(ws + WS_XB);
    for (int m = c.gw; m < M; m += 2 * c.NGW) {
        const int m2 = m + c.NGW;
        const f32x4* xr = (const f32x4*)(x + (size_t)m * D) + c.lane; const f32x4* xq = (const f32x4*)(x + (size_t)m2 * D) + c.lane; f32x4 v[4], w[4]; float s = 0.f, s2 = 0.f;
#pragma unroll
        for (int j = 0; j < 4; ++j) { v[j] = xr[64 * j]; w[j] = xq[64 * j]; }
#pragma unroll
        for (int j = 0; j < 4; ++j) { s += (v[j].x * v[j].x + v[j].y * v[j].y) + (v[j].z * v[j].z + v[j].w * v[j].w); s2 += (w[j].x * w[j].x + w[j].y * w[j].y) + (w[j].z * w[j].z + w[j].w * w[j].w); }
        const float rs = rsqrtf(wave_sum(s) * (1.f / D) + NORM_EPS), rs2 = rsqrtf(wave_sum(s2) * (1.f / D) + NORM_EPS);
        u32x2* o8 = (u32x2*)(H1 + (size_t)m * D) + c.lane; u32x2* o9 = (u32x2*)(H1 + (size_t)m2 * D) + c.lane;
#pragma unroll
        for (int j = 0; j < 4; ++j) { u32x2 o; o.x = pk2(v[j].x * rs, v[j].y * rs); o.y = pk2(v[j].z * rs, v[j].w * rs); o8[64 * j] = o;
            u32x2 q; q.x = pk2(w[j].x * rs2, w[j].y * rs2); q.y = pk2(w[j].z * rs2, w[j].w * rs2); o9[64 * j] = q; }
    }
    const f32x4* pp = (const f32x4*)p.in[I_P]; u32x2* pb = (u32x2*)(ws + WS_PB);
    for (int i = blockIdx.x * NTHR + c.tid; i < M * PLED / 4; i += c.G * NTHR) { const f32x4 v = pp[i]; u32x2 o; o.x = pk2(v.x, v.y); o.y = pk2(v.z, v.w); pb[i] = o; }
}

__device__ __forceinline__ void phase2a(const P& p, const Ctx& c) {
    unsigned char* ws = p.ws;
    const bf16* ZLOW = (const bf16*)(ws + WS_ZLOW); bf16* A2 = (bf16*)((unsigned char*)p.out + O_A2);
    const f32x4 mu = *(const f32x4*)(p.in[I_MU] + 1536 + 4 * c.lane);
    for (int m = c.gw; m < M; m += c.NGW) {
        const u32x2 z = *(const u32x2*)(ZLOW + (size_t)m * 256 + 4 * c.lane);
        u32x2 zp = {0u, 0u}; if ((m & (T - 1)) != 0) zp = *(const u32x2*)(ZLOW + (size_t)(m - 1) * 256 + 4 * c.lane);
        float v[4] = {bflo(z.x), bfhi(z.x), bflo(z.y), bfhi(z.y)}; const float q[4] = {bflo(zp.x), bfhi(zp.x), bflo(zp.y), bfhi(zp.y)};
#pragma unroll
        for (int e = 0; e < 4; ++e) { v[e] = v[e] + (q[e] - v[e]) * mu[e];
            if (c.lane < 16) v[e] = 1.f - 2.f / (1.f + __expf(2.f * v[e])); else if (c.lane >= 32) v[e] = sigmoidf_(v[e]); }
        u32x2 o; o.x = pk2(v[0], v[1]); o.y = pk2(v[2], v[3]); *(u32x2*)(A2 + (size_t)m * 256 + 4 * c.lane) = o;
    }
    const bf16* V = (const bf16*)(ws + WS_V); bf16* VT = (bf16*)((unsigned char*)p.out + O_VT);
    unsigned short* s16 = (unsigned short*)(c.lds + c.wave * 16384);
    for (int it = c.gw; it < NB * NH * 64; it += c.NGW) {
        const int bh = it >> 6, tb = it & 63, b = bh >> 3, h = bh & 7; const size_t m0 = (size_t)b * T + tb * 64;
#pragma unroll
        for (int i = 0; i < 8; ++i) { const int id = i * 64 + c.lane, tt = id >> 3, dg = id & 7;
            *(u32x4*)(s16 + tt * 72 + dg * 8) = *(const u32x4*)(V + (m0 + tt) * 512 + h * 64 + dg * 8); }
        asm volatile("s_waitcnt lgkmcnt(0)" ::: "memory");
#pragma unroll
        for (int i = 0; i < 8; ++i) { const int d = c.lane; const unsigned short* s = s16 + (8 * i) * 72 + d;
            u32x4 o; o.x = s[0] | ((unsigned)s[72] << 16); o.y = s[144] | ((unsigned)s[216] << 16); o.z = s[288] | ((unsigned)s[360] << 16); o.w = s[432] | ((unsigned)s[504] << 16);
            *(u32x4*)(VT + ((size_t)(bh * 64 + d)) * T + tb * 64 + 8 * i) = o; }
        asm volatile("s_waitcnt lgkmcnt(0)" ::: "memory");
    }
}

__device__ __forceinline__ unsigned h2pack(float a, float b) { return (unsigned)f2h(a) | ((unsigned)f2h(b) << 16); }
__device__ __forceinline__ void phase2c(const P& p, const Ctx& c) {
    unsigned char* ws = p.ws;
    const bf16* ZRM = (const bf16*)(ws + WS_ZRM); const bf16* A = (const bf16*)((unsigned char*)p.out + O_A);
    unsigned char* PACK = ws + WS_PACK; float* BONUS = (float*)(ws + WS_BONUS);
    const int hq = c.lane >> 4, js = c.lane & 15;
    for (int wi = c.gw; wi < 2048; wi += c.NGW) {
        const int hh = wi & 1, chunk = wi >> 1, h = 4 * hh + hq, col = h * 64 + 4 * js; const int mb = chunk * 32;
        const f32x4 mur = *(const f32x4*)(p.in[I_MU] + col), muk = *(const f32x4*)(p.in[I_MU] + 512 + col), muv = *(const f32x4*)(p.in[I_MU] + 1024 + col);
        const f32x4 kkw = *(const f32x4*)(p.in[I_KK] + col), kaw = *(const f32x4*)(p.in[I_KA] + col), rkw = *(const f32x4*)(p.in[I_RK] + col);
        f32x4 pr = {0.f, 0.f, 0.f, 0.f}, pk = pr, pv = pr;
        if ((mb & (T - 1)) != 0) { const bf16* z = ZRM + (size_t)(mb - 1) * 1536 + col; const u32x2 a_ = *(const u32x2*)z, b_ = *(const u32x2*)(z + 512), c_ = *(const u32x2*)(z + 1024);
            pr = (f32x4){bflo(a_.x), bfhi(a_.x), bflo(a_.y), bfhi(a_.y)}; pk = (f32x4){bflo(b_.x), bfhi(b_.x), bflo(b_.y), bfhi(b_.y)}; pv = (f32x4){bflo(c_.x), bfhi(c_.x), bflo(c_.y), bfhi(c_.y)}; }
        const int b = mb / T, t0 = mb % T;
        unsigned char* rec = PACK + ((size_t)((b * NH + h) * T + t0)) * REC + 8 * js;
#pragma unroll 4
        for (int i = 0; i < 32; ++i) {
            const int m = mb + i; const bf16* z = ZRM + (size_t)m * 1536 + col;
            const u32x2 a_ = *(const u32x2*)z, b_ = *(const u32x2*)(z + 512), c_ = *(const u32x2*)(z + 1024), d_ = *(const u32x2*)(A + (size_t)m * 512 + col);
            const f32x4 zr = {bflo(a_.x), bfhi(a_.x), bflo(a_.y), bfhi(a_.y)}, zk = {bflo(b_.x), bfhi(b_.x), bflo(b_.y), bfhi(b_.y)}, zv = {bflo(c_.x), bfhi(c_.x), bflo(c_.y), bfhi(c_.y)}, av = {bflo(d_.x), bfhi(d_.x), bflo(d_.y), bfhi(d_.y)};
            const f32x4 r = zr + (pr - zr) * mur, k = zk + (pk - zk) * muk, v = zv + (pv - zv) * muv; pr = zr; pk = zk; pv = zv;
            const f32x4 kkv = k * kkw; const float ss = allreduce16((kkv.x * kkv.x + kkv.y * kkv.y) + (kkv.z * kkv.z + kkv.w * kkv.w));
            const f32x4 kk = kkv * (1.f / fmaxf(sqrtf(ss), 1e-12f));
            const f32x4 kp = k * (1.f + (av - 1.f) * kaw), bb = kk * av, rb = r * kp * rkw;
            const float bon = allreduce16((rb.x + rb.y) + (rb.z + rb.w));
            unsigned char* q = rec + (size_t)i * REC;
            u32x2 o; o.x = h2pack(-kk.x, -kk.y); o.y = h2pack(-kk.z, -kk.w); *(u32x2*)q = o;
            o.x = h2pack(bb.x, bb.y); o.y = h2pack(bb.z, bb.w); *(u32x2*)(q + 128) = o;
            o.x = h2pack(kp.x, kp.y); o.y = h2pack(kp.z, kp.w); *(u32x2*)(q + 256) = o;
            o.x = h2pack(r.x, r.y); o.y = h2pack(r.z, r.w); *(u32x2*)(q + 384) = o;
            o.x = h2pack(v.x, v.y); o.y = h2pack(v.z, v.w); *(u32x2*)(q + 512) = o;
            if (js == 0) BONUS[(size_t)m * NH + h] = bon;
        }
    }
}

typedef _Float16 h2t __attribute__((ext_vector_type(2)));
__device__ __forceinline__ float mixz_lo(unsigned h, float b) { float d; asm("v_fma_mix_f32 %0, %1, %2, 0 op_sel:[0,0,0] op_sel_hi:[1,0,0]" : "=v"(d) : "v"(h), "v"(b)); return d; }
__device__ __forceinline__ float mix_lo(unsigned h, float b, float c) { float d; asm("v_fma_mix_f32 %0, %1, %2, %3 op_sel:[0,0,0] op_sel_hi:[1,0,0]" : "=v"(d) : "v"(h), "v"(b), "v"(c)); return d; }
__device__ __forceinline__ float mix_hi(unsigned h, float b, float c) { float d; asm("v_fma_mix_f32 %0, %1, %2, %3 op_sel:[1,0,0] op_sel_hi:[1,0,0]" : "=v"(d) : "v"(h), "v"(b), "v"(c)); return d; }
__device__ __forceinline__ float mix2z_ll(unsigned h, unsigned g) { float d; asm("v_fma_mix_f32 %0, %1, %2, 0 op_sel:[0,0,0] op_sel_hi:[1,1,0]" : "=v"(d) : "v"(h), "v"(g)); return d; }
__device__ __forceinline__ float mix2z_lh(unsigned h, unsigned g) { float d; asm("v_fma_mix_f32 %0, %1, %2, 0 op_sel:[0,1,0] op_sel_hi:[1,1,0]" : "=v"(d) : "v"(h), "v"(g)); return d; }
#define SC_G(chsrc, buf) do { const unsigned char* _g = src + (size_t)(chsrc) * 7168 + lane * 16; \
        _Pragma("unroll") for (int _i = 0; _i < 7; ++_i) __builtin_amdgcn_global_load_lds((const unsigned*)(_g + _i * 1024), (PG8_LAS unsigned*)(ldsw + (buf) * 7168 + _i * 1024), 16, 0, 0); } while (0)
#define SC_RD(X, buf, i) do { const int _o = (buf) * 7168 + (i) * REC; nk##X = *(const PG8_LAS u32x2*)(pj + _o); bq##X = *(const PG8_LAS u32x2*)(pj + _o + 128); kq##X = *(const PG8_LAS u32x2*)(pj + _o + 256); rq##X = *(const PG8_LAS u32x2*)(pj + _o + 384); \
        vh##X = *(const PG8_LAS unsigned short*)(pv + _o); dd##X = *(const PG8_LAS f32x4*)(pd + _o); } while (0)
#define SC_CP(X, par, i, Y, nbuf, ni) do { \
        SC_RD(Y, nbuf, ni); __builtin_amdgcn_sched_barrier(0); \
        float pp_ = mixz_lo(nk##X.x, S0); float pq_ = mixz_lo(nk##X.y, S2); \
        yq = dpp_add<0xB1>(yq); \
        pp_ = mix_hi(nk##X.x, S1, pp_); pq_ = mix_hi(nk##X.y, S3, pq_); \
        yq = dpp_add<0x4E>(yq); \
        float sa = pp_ + pq_; \
        yq = dpp_add<0x141>(yq); \
        sa = dpp_add<0xB1>(sa); \
        yq = dpp_add<0x140>(yq); \
        sa = dpp_add<0x4E>(sa); \
        ykeep = (js == (par) * 8 + (i) - 1) ? yq : ykeep; \
        sa = dpp_add<0x141>(sa); sa = dpp_add<0x140>(sa); \
        tc0 = mix_lo(bq##X.x, sa, tc0); tc1 = mix_hi(bq##X.x, sa, tc1); tc2 = mix_lo(bq##X.y, sa, tc2); tc3 = mix_hi(bq##X.y, sa, tc3); \
        S0 = fmaf(S0, dd##X.x, tc0); S1 = fmaf(S1, dd##X.y, tc1); S2 = fmaf(S2, dd##X.z, tc2); S3 = fmaf(S3, dd##X.w, tc3); \
        float y0_ = mixz_lo(rq##X.x, S0); float y1_ = mixz_lo(rq##X.y, S2); \
        tc0 = mix2z_ll(vh##Y, kq##Y.x); tc1 = mix2z_lh(vh##Y, kq##Y.x); \
        y0_ = mix_hi(rq##X.x, S1, y0_); y1_ = mix_hi(rq##X.y, S3, y1_); \
        tc2 = mix2z_ll(vh##Y, kq##Y.y); tc3 = mix2z_lh(vh##Y, kq##Y.y); \
        yq = y0_ + y1_; __builtin_amdgcn_sched_barrier(0); } while (0)
#define SC_YOUT(off) do { const float yl_ = allreduce16(yq); ykeep = (js == 15) ? yl_ : ykeep; yp[(size_t)(ch * 8 + (off)) * 512] = (bf16)f2bf(ykeep); yq = 0.f; } while (0)
#define SC_EIGHT(buf, par) do { \
        SC_CP(0, par, 0, 1, buf, 1); SC_CP(1, par, 1, 0, buf, 2); SC_CP(0, par, 2, 1, buf, 3); SC_CP(1, par, 3, 0, buf, 4); \
        SC_CP(0, par, 4, 1, buf, 5); SC_CP(1, par, 5, 0, buf, 6); SC_CP(0, par, 6, 1, buf, 7); SC_CP(1, par, 7, 0, ((buf) + 1) & 3, 0); } while (0)
#define SC_HEAD(k) do { { const int nx = (ch + (k) + 3 < NCH) ? ch + (k) + 3 : NCH - 1; SC_G(nx, ((k) + 3) & 3); } asm volatile("s_waitcnt vmcnt(14)" ::: "memory"); __builtin_amdgcn_sched_barrier(0); } while (0)

__device__ __forceinline__ void scan_unit(const unsigned char* pack, bf16* Y, PG8_LAS unsigned char* ldsw, int unit, int w, int lane) {
    const int xcd_ = unit & 7, idx_ = unit >> 3, bh = xcd_ * 8 + (idx_ >> 2), rg = idx_ & 3, b = bh >> 3, h = bh & 7;
    const int rr = lane >> 4, js = lane & 15, row = rg * 16 + w * 4 + rr;
    const unsigned char* src = pack + (size_t)bh * T * REC;
    bf16* yp = Y + ((size_t)b * T + js) * 512 + h * 64 + row;
    const PG8_LAS unsigned char* pj = ldsw + 8 * js; const PG8_LAS unsigned char* pv = ldsw + 512 + 2 * row; const PG8_LAS unsigned char* pd = ldsw + 640 + 16 * js;
    u32x2 nk0, bq0, kq0, rq0, nk1, bq1, kq1, rq1; unsigned vh0, vh1; f32x4 dd0, dd1;
    float S0 = 0.f, S1 = 0.f, S2 = 0.f, S3 = 0.f, ykeep = 0.f, yq = 0.f;
    constexpr int NCH = T / 8;
    SC_G(0, 0); SC_G(1, 1); SC_G(2, 2);
    asm volatile("s_waitcnt vmcnt(14)" ::: "memory");
    SC_RD(0, 0, 0);
    float tc0 = mix2z_ll(vh0, kq0.x), tc1 = mix2z_lh(vh0, kq0.x), tc2 = mix2z_ll(vh0, kq0.y), tc3 = mix2z_lh(vh0, kq0.y);
#pragma unroll 1
    for (int ch = 0; ch < NCH; ch += 4) {
        SC_HEAD(0); SC_EIGHT(0, 0);
        SC_HEAD(1); SC_EIGHT(1, 1);
        SC_YOUT(0);
        SC_HEAD(2); SC_EIGHT(2, 0);
        SC_HEAD(3); SC_EIGHT(3, 1);
        SC_YOUT(16);
    }
    asm volatile("s_waitcnt vmcnt(0)" ::: "memory");
}

#if defined(PROBE_FAKE)
__device__ __forceinline__ void scan_fake(bf16* Y, PG8_LAS unsigned char* ldsw, int lane, int nch) {
    const int js = lane & 15, row = lane >> 4;
    const PG8_LAS unsigned char* pj = ldsw + 8 * js; const PG8_LAS unsigned char* pv = ldsw + 512 + 2 * row; const PG8_LAS unsigned char* pd = ldsw + 640 + 16 * js;
    u32x2 nk0, bq0, kq0, rq0, nk1, bq1, kq1, rq1; unsigned vh0, vh1; f32x4 dd0, dd1;
    float S0 = 0.f, S1 = 0.f, S2 = 0.f, S3 = 0.f, ykeep = 0.f, yq = 0.f;
    SC_RD(0, 0, 0);
    float tc0 = 0.f, tc1 = 0.f, tc2 = 0.f, tc3 = 0.f;
#pragma unroll 1
    for (int ch = 0; ch < nch; ch += 4) { SC_EIGHT(0, 0); SC_EIGHT(1, 1); SC_EIGHT(2, 0); SC_EIGHT(3, 1); }
    if (S0 + S1 + S2 + S3 + ykeep + yq == 1.2345e30f) Y[lane] = (bf16)1;
}
#endif

__device__ __forceinline__ void attn_item(const bf16* QK, const bf16* VT, bf16* OAB, const float* tab, int item, int lane) {
    const int qh = item & 1, cq = (item >> 1) & 63, bh = item >> 7, b = bh >> 3, h = bh & 7;
    const int n = lane & 31, hi = lane >> 5;
    const size_t mq = (size_t)b * T + cq * 64 + qh * 32 + n;
    bf16x8 bq[4];
#pragma unroll
    for (int s = 0; s < 4; ++s) bq[s] = *(const bf16x8*)(QK + mq * 1024 + h * 64 + 16 * s + 8 * hi);
    f32x16 o0, o1;
#pragma unroll
    for (int i = 0; i < 16; ++i) { o0[i] = 0.f; o1[i] = 0.f; }
    float mrun = -1e30f, lrun = 0.f;
    const int pin = (n & ~12) | ((n & 4) << 1) | ((n & 8) >> 1);
    const float* tabh = tab + h * 256; const float c191 = tabh[191];
    for (int j = (cq < 8 ? 8 - cq : 0); j <= 8; ++j) {
        const int kc = cq - 8 + j; const size_t mk0 = (size_t)b * T + (size_t)kc * 64;
        f32x16 x0, x1;
#pragma unroll
        for (int i = 0; i < 16; ++i) { x0[i] = 0.f; x1[i] = 0.f; }
        const bf16* kp0 = QK + (mk0 + pin) * 1024 + 512 + h * 64 + 8 * hi;
#pragma unroll
        for (int s = 0; s < 4; ++s) { const bf16x8 a0 = *(const bf16x8*)(kp0 + 16 * s), a1 = *(const bf16x8*)(kp0 + 32 * 1024 + 16 * s); x0 = MFMA32(a0, bq[s], x0); x1 = MFMA32(a1, bq[s], x1); }
        if (j <= 5) {
#pragma unroll
            for (int i = 0; i < 16; ++i) { x0[i] += c191; x1[i] += c191; }
        } else {
            const float* lp = tabh + (32 * qh + n - 8 * hi + 64 * (8 - j) + 8);
#pragma unroll
            for (int i = 0; i < 16; ++i) { const int ct = 16 * (i >> 3) + 4 * ((i >> 2) & 1) + (i & 3); x0[i] += lp[55 - ct]; x1[i] += lp[23 - ct]; }
        }
        float mx = fmaxf(x0[0], x1[0]);
#pragma unroll
        for (int i = 1; i < 16; ++i) mx = fmaxf(mx, fmaxf(x0[i], x1[i]));
        mx = fmaxf(mx, __shfl_xor(mx, 32));
        const float mnew = fmaxf(mrun, mx), alpha = __builtin_amdgcn_exp2f(mrun - mnew); mrun = mnew;
        float ls = 0.f;
#pragma unroll
        for (int i = 0; i < 16; ++i) { x0[i] = __builtin_amdgcn_exp2f(x0[i] - mnew); x1[i] = __builtin_amdgcn_exp2f(x1[i] - mnew); ls += x0[i] + x1[i]; }
        lrun = lrun * alpha + ls;
#pragma unroll
        for (int i = 0; i < 16; ++i) { o0[i] *= alpha; o1[i] *= alpha; }
        const bf16* vp = VT + ((size_t)(bh * 64 + n)) * T + (size_t)kc * 64 + 8 * hi;
#pragma unroll
        for (int s2 = 0; s2 < 2; ++s2) {
            { const bf16x8 v0 = *(const bf16x8*)(vp + 16 * s2), v1 = *(const bf16x8*)(vp + (size_t)32 * T + 16 * s2); const bf16x8 pb = packstep(x0, s2); o0 = MFMA32(v0, pb, o0); o1 = MFMA32(v1, pb, o1); }
            { const bf16x8 v0 = *(const bf16x8*)(vp + 32 + 16 * s2), v1 = *(const bf16x8*)(vp + (size_t)32 * T + 32 + 16 * s2); const bf16x8 pb = packstep(x1, s2); o0 = MFMA32(v0, pb, o0); o1 = MFMA32(v1, pb, o1); }
        }
    }
    lrun += __shfl_xor(lrun, 32); const float inv = 1.f / lrun;
    bf16* op = OAB + mq * 1024 + 512 + h * 64 + 4 * hi;
#pragma unroll
    for (int g = 0; g < 4; ++g) {
        u32x2 w0, w1; w0.x = cvtpk(o0[4 * g] * inv, o0[4 * g + 1] * inv); w0.y = cvtpk(o0[4 * g + 2] * inv, o0[4 * g + 3] * inv);
        w1.x = cvtpk(o1[4 * g] * inv, o1[4 * g + 1] * inv); w1.y = cvtpk(o1[4 * g + 2] * inv, o1[4 * g + 3] * inv);
        *(u32x2*)(op + 8 * g) = w0; *(u32x2*)(op + 32 + 8 * g) = w1;
    }
}

__device__ __forceinline__ void phase3(const P& p, const Ctx& c) {
    unsigned char* ws = p.ws;
    float* tab = (float*)(c.lds + 4 * 28672);
    for (int i = c.tid; i < NH * 256; i += NTHR) { const int h = i >> 8, r = i & 255; tab[i] = p.in[I_REL][h * 192 + (r < 191 ? r : 191)] * LOG2E; }
    __syncthreads();
    if (c.wave < 4) {
        __builtin_amdgcn_s_setprio(3);
#ifndef PROBE_SCAN
#define PROBE_SCAN 1
#endif
        for (int rp_ = 0; rp_ < PROBE_SCAN; ++rp_)
        for (int unit = blockIdx.x; unit < 256; unit += c.G)
            scan_unit(ws + WS_PACK, (bf16*)((unsigned char*)p.out + O_Y), (PG8_LAS unsigned char*)c.lds + c.wave * 28672, unit, c.wave, c.lane);
        __builtin_amdgcn_s_setprio(0);
    } else {
        const int aw = blockIdx.x * 4 + (c.wave - 4), NAW = c.G * 4;
#ifndef PROBE_ATT
#define PROBE_ATT 1
#endif
        for (int rp_ = 0; rp_ < PROBE_ATT; ++rp_)
        for (int item = aw; item < NB * NH * 64 * 2; item += NAW)
            attn_item((const bf16*)(ws + WS_QK), (const bf16*)((unsigned char*)p.out + O_VT), (bf16*)(ws + WS_OAB), tab, item, c.lane);
#if defined(PROBE_FAKE)
        scan_fake((bf16*)((unsigned char*)p.out + O_Y), (PG8_LAS unsigned char*)c.lds + (c.wave - 4) * 28672, c.lane, PROBE_FAKE);
#endif
    }
}

__device__ __forceinline__ void phase35a(const P& p, const Ctx& c) {
    unsigned char* ws = p.ws;
    const bf16* Y = (const bf16*)((unsigned char*)p.out + O_Y); const bf16* Gm = (const bf16*)((unsigned char*)p.out + O_G);
    const unsigned char* PACK = ws + WS_PACK; const float* BONUS = (const float*)(ws + WS_BONUS); bf16* OAB = (bf16*)(ws + WS_OAB);
    const int hq = c.lane >> 4, js = c.lane & 15;
    for (int wi = c.gw; wi < 2048; wi += c.NGW) {
        const int hh = wi & 1, chunk = wi >> 1, h = 4 * hh + hq, col = h * 64 + 4 * js, mb = chunk * 32, b = mb / T, t0 = mb % T;
        const f32x4 lw = *(const f32x4*)(p.in[I_LNXW] + col), lb = *(const f32x4*)(p.in[I_LNXB] + col);
        const unsigned char* rec = PACK + ((size_t)((b * NH + h) * T + t0)) * REC + 512 + 8 * js;
#pragma unroll 4
        for (int i = 0; i < 32; ++i) {
            const size_t m = (size_t)(mb + i);
            const u32x2 y_ = *(const u32x2*)(Y + m * 512 + col), g_ = *(const u32x2*)(Gm + m * 512 + col), v_ = *(const u32x2*)(rec + (size_t)i * REC);
            const f32x4 y = {bflo(y_.x), bfhi(y_.x), bflo(y_.y), bfhi(y_.y)}, g = {bflo(g_.x), bfhi(g_.x), bflo(g_.y), bfhi(g_.y)};
            const h4 vh = __builtin_bit_cast(h4, v_); const f32x4 v = {(float)vh.x, (float)vh.y, (float)vh.z, (float)vh.w};
            const float mean = allreduce16((y.x + y.y) + (y.z + y.w)) * (1.f / 64); const f32x4 dy = y - mean;
            const float var = allreduce16((dy.x * dy.x + dy.y * dy.y) + (dy.z * dy.z + dy.w * dy.w)) * (1.f / 64);
            const f32x4 o = (dy * rsqrtf(var + GN_EPS) * lw + lb + v * BONUS[m * NH + h]) * g;
            u32x2 w; w.x = pk2(o.x, o.y); w.y = pk2(o.z, o.w); *(u32x2*)(OAB + m * 1024 + col) = w;
        }
    }
}

__device__ __forceinline__ void phase5b(const P& p, const Ctx& c, int wr) {
    bf16* U = (bf16*)(p.ws + WS_U);
    const float* cw = p.in[I_CONVW]; const float* cb = p.in[I_CONVB];
    constexpr int RUN = 16, NCH16 = DFF / 8;
    const int total = (M / RUN) * NCH16;
    for (int it = blockIdx.x * NTHR + c.tid; it < total; it += c.G * NTHR) {
        const int run = it / NCH16, ck = it % NCH16, ch0 = ck * 8, blk = ch0 >> 7, j0 = ch0 & 127;
        const int m0 = run * RUN, t0 = m0 & (T - 1);
        float w0[8], w1[8], w2[8], bb[8];
#pragma unroll
        for (int e = 0; e < 8; ++e) { w0[e] = cw[ch0 + e]; w1[e] = cw[DFF + ch0 + e]; w2[e] = cw[2 * DFF + ch0 + e]; bb[e] = cb[ch0 + e]; }
        bf16* ua = U + (size_t)m0 * NUP + 256 * blk + j0;
        float a1[8], a2[8];
        if (t0 == 0) {
#pragma unroll
            for (int e = 0; e < 8; ++e) { a1[e] = 0.f; a2[e] = 0.f; }
        } else {
            f32x4 x0, x1; unpack8(*(const u32x4*)(ua - NUP), x0, x1); f32x4 y0, y1; unpack8(*(const u32x4*)(ua - 2 * NUP), y0, y1);
#pragma unroll
            for (int e = 0; e < 4; ++e) { a1[e] = x0[e]; a1[4 + e] = x1[e]; a2[e] = y0[e]; a2[4 + e] = y1[e]; }
        }
#pragma unroll 4
        for (int i = 0; i < RUN; ++i) {
            bf16* ur = ua + (size_t)i * NUP;
            f32x4 x0, x1, g0, g1; unpack8(*(const u32x4*)ur, x0, x1); unpack8(*(const u32x4*)(ur + 128), g0, g1);
            float a0[8], r[8];
#pragma unroll
            for (int e = 0; e < 4; ++e) { a0[e] = x0[e]; a0[4 + e] = x1[e]; }
#pragma unroll
            for (int e = 0; e < 8; e += 2) {
                f32x2 cv; cv.x = bb[e] + w0[e] * a2[e] + w1[e] * a1[e] + w2[e] * a0[e]; cv.y = bb[e + 1] + w0[e + 1] * a2[e + 1] + w1[e + 1] * a1[e + 1] + w2[e + 1] * a0[e + 1];
                const f32x2 ge = pg8::gelu_pk(cv); r[e] = ge.x; r[e + 1] = ge.y;
            }
#pragma unroll
            for (int e = 0; e < 8; ++e) { a2[e] = a1[e]; a1[e] = a0[e]; }
            f32x4 r0 = {r[0] * g0[0], r[1] * g0[1], r[2] * g0[2], r[3] * g0[3]}, r1 = {r[4] * g1[0], r[5] * g1[1], r[6] * g1[2], r[7] * g1[3]};
            if (wr) *(u32x4*)(ur + 128) = pack8(r0, r1);
        }
    }
}

__device__ __forceinline__ void phase5b_fix(const P& p, const Ctx& c) {
    bf16* U = (bf16*)(p.ws + WS_U);
    const float* cw = p.in[I_CONVW]; const float* cb = p.in[I_CONVB];
    constexpr int NCH16 = DFF / 8;
    const int total = (M / 32) * NCH16;
    for (int it = blockIdx.x * NTHR + c.tid; it < total; it += c.G * NTHR) {
        const int rid = it / NCH16, ck = it % NCH16, ch0 = ck * 8, blk = ch0 >> 7, j0 = ch0 & 127;
        const int m = (rid >> 1) * 64 + (rid & 1), t = m & (T - 1);
        bf16* ur = U + (size_t)m * NUP + 256 * blk + j0;
        f32x4 x0, x1, g0, g1, y0 = {0.f, 0.f, 0.f, 0.f}, y1 = y0, z0 = y0, z1 = y0;
        unpack8(*(const u32x4*)ur, x0, x1); unpack8(*(const u32x4*)(ur + 128), g0, g1);
        if (t >= 1) unpack8(*(const u32x4*)(ur - NUP), y0, y1);
        if (t >= 2) unpack8(*(const u32x4*)(ur - 2 * NUP), z0, z1);
        const f32x4 w00 = *(const f32x4*)(cw + ch0), w01 = *(const f32x4*)(cw + ch0 + 4), w10 = *(const f32x4*)(cw + DFF + ch0), w11 = *(const f32x4*)(cw + DFF + ch0 + 4);
        const f32x4 w20 = *(const f32x4*)(cw + 2 * DFF + ch0), w21 = *(const f32x4*)(cw + 2 * DFF + ch0 + 4), b0 = *(const f32x4*)(cb + ch0), b1 = *(const f32x4*)(cb + ch0 + 4);
        const f32x4 c0 = b0 + w00 * z0 + w10 * y0 + w20 * x0, c1 = b1 + w01 * z1 + w11 * y1 + w21 * x1;
        const f32x2 e0 = pg8::gelu_pk((f32x2){c0[0], c0[1]}), e1 = pg8::gelu_pk((f32x2){c0[2], c0[3]}), e2 = pg8::gelu_pk((f32x2){c1[0], c1[1]}), e3 = pg8::gelu_pk((f32x2){c1[2], c1[3]});
        const f32x4 r0 = {e0.x * g0[0], e0.y * g0[1], e1.x * g0[2], e1.y * g0[3]}, r1 = {e2.x * g1[0], e2.y * g1[1], e3.x * g1[2], e3.y * g1[3]};
        *(u32x4*)(ur + 128) = pack8(r0, r1);
    }
}

__device__ __forceinline__ void phase8(const P& p, const Ctx& c, int wr) {
    const float* SSF = (const float*)(p.ws + WS_SSF); const f32x4* gf = (const f32x4*)p.in[I_LNF] + c.lane;
    f32x4 g[4];
#pragma unroll
    for (int j = 0; j < 4; ++j) g[j] = gf[64 * j];
    for (int m = c.gw; m < M; m += 2 * c.NGW) {
        const int m2 = m + c.NGW;
        const float rs = rsqrtf(SSF[m] * (1.f / D) + NORM_EPS), rs2 = rsqrtf(SSF[m2] * (1.f / D) + NORM_EPS);
        f32x4* xr = (f32x4*)(p.out + (size_t)m * D) + c.lane; f32x4* xq = (f32x4*)(p.out + (size_t)m2 * D) + c.lane;
        f32x4 v[4], w[4];
#pragma unroll
        for (int j = 0; j < 4; ++j) { v[j] = xr[64 * j]; w[j] = xq[64 * j]; }
#pragma unroll
        for (int j = 0; j < 4; ++j) { const f32x4 v_ = v[j] * rs * g[j], w_ = w[j] * rs2 * g[j]; if (wr) { xr[64 * j] = v_; xq[64 * j] = w_; } else if (v_.x == 1.2345e-30f) xr[64 * j] = w_; }
    }
}

constexpr int NPHASE = 16;
__global__ void __launch_bounds__(NTHR, 2) mk_fwd(P p) {
    extern __shared__ __attribute__((aligned(16))) unsigned char lds[];
    cg::grid_group grid = cg::this_grid();
    const int wave_s = __builtin_amdgcn_readfirstlane((int)(threadIdx.x >> 6));
    volatile PG8_LAS unsigned* misc = (volatile PG8_LAS unsigned*)((PG8_LAS unsigned char*)lds + 131072 + 320);
    if (threadIdx.x < 32) misc[threadIdx.x] = 0u;
    __syncthreads();
    if (p.ph_lo < 0) grid.sync();
    const XcdBarrier xbar = xcd_barrier_post((unsigned*)(p.ws + WS_BAR), misc + 8);
#define MKCTX Ctx c; c.lds = lds; c.lane = vlane_id(); c.wave = wave_s; c.tid = wave_s * 64 + c.lane; c.G = gridDim.x; c.gw = blockIdx.x * NWAVES + c.wave; c.NGW = c.G * NWAVES;
    unsigned char* ws = p.ws; unsigned char* ob = (unsigned char*)p.out;
    PG8_LAS unsigned char* ring = (PG8_LAS unsigned char*)lds;
    const int lo = p.ph_lo, hi = p.ph_hi;
#ifndef FUSE_ALIGN
#define FUSE_ALIGN true
#endif
#ifndef PROBE_REP
#define PROBE_REP 0
#endif
#ifndef PROBE_BAR2
#define PROBE_BAR2 0
#endif
#define REPS(k) (1 + ((PROBE_REP >> (k)) & 1))
#ifndef PH_MASK
#define PH_MASK 0xFFFF
#endif
#define IN(k) (((PH_MASK >> (k)) & 1) && lo <= (k) && (k) < hi)
#define SEAM(k) do { if (IN(k) && IN((k) + 1)) { { xcd_barrier(xbar, wave_s * 64 + vlane_id()); if (PROBE_BAR2) xcd_barrier(xbar, wave_s * 64 + vlane_id()); } } } while (0)
    typedef pg8::StaticOrder SO;
    if (IN(0)) for (int rep_ = 0; rep_ < REPS(0); ++rep_) { MKCTX phase0(p, c); } SEAM(0);
    if (IN(1)) for (int rep_ = 0; rep_ < REPS(1); ++rep_) { pg8::Gemm g{(const bf16*)(ws + WS_XB), (const bf16*)(ws + WS_WIN), M, ZMAIN, D, D, 256}; SO S; S.init(M, ZMAIN, gridDim.x, blockIdx.x);
        EpiZ E{(bf16*)(ws + WS_ZRM), (bf16*)(ws + WS_ZLOW), (bf16*)(ws + WS_QK), (bf16*)(ws + WS_V)};
        pg8::gemm_phase<EpiZ, SO, true>(ring, g, S, E, wave_s, vlane_id()); } SEAM(1);
    if (IN(2)) for (int rep_ = 0; rep_ < REPS(2); ++rep_) { MKCTX phase2a(p, c); } SEAM(2);
    if (IN(3)) for (int rep_ = 0; rep_ < REPS(3); ++rep_) { pg8::Gemm g{(const bf16*)(ob + O_A2), (const bf16*)(ws + WS_BT2), M, 1536, 256, 256, 256}; SO S; S.init(M, 1536, gridDim.x, blockIdx.x);
        EpiLR E{ws + WS_PACK, (bf16*)(ob + O_A), (bf16*)(ob + O_G), p.in[I_W0], p.in[I_A0]};
        pg8::gemm_phase<EpiLR, SO, true>(ring, g, S, E, wave_s, vlane_id()); } SEAM(3);
    if (IN(4)) for (int rep_ = 0; rep_ < REPS(4); ++rep_) { MKCTX phase2c(p, c); } SEAM(4);
    if (IN(5)) for (int rep_ = 0; rep_ < REPS(5); ++rep_) { MKCTX phase3(p, c); } SEAM(5);
    if (IN(6)) for (int rep_ = 0; rep_ < REPS(6); ++rep_) { MKCTX phase35a(p, c); } SEAM(6);
    if (IN(7)) for (int rep_ = 0; rep_ < REPS(7); ++rep_) { pg8::Gemm g{(const bf16*)(ws + WS_XB), (const bf16*)(ws + WS_WIN) + (size_t)ZMAIN * D, M, NGATE, D, D, 256}; SO S; S.init(M, NGATE, gridDim.x, blockIdx.x);
        EpiGate E{(bf16*)(ws + WS_GATES), p.in[I_GATEB]};
        pg8::gemm_phase<EpiGate, SO, true>(ring, g, S, E, wave_s, vlane_id()); } SEAM(7);
    if (IN(8)) for (int rep_ = 0; rep_ < REPS(8); ++rep_) { pg8::Gemm g{(const bf16*)(ws + WS_OAB), (const bf16*)(ws + WS_WBR), M, D, D, D, 256}; SO S; S.init(M, D, gridDim.x, blockIdx.x);
        EpiMerge E{(const bf16*)(ws + WS_GATES), (bf16*)(ws + WS_MERGED)};
        pg8::gemm_phase<EpiMerge, SO, true>(ring, g, S, E, wave_s, vlane_id()); } SEAM(8);
    if (IN(9)) for (int rep_ = 0; rep_ < REPS(9); ++rep_) { pg8::Gemm g{(const bf16*)(ws + WS_MERGED), (const bf16*)(ws + WS_WO), M, D, D, D, 256}; SO S; S.init(M, D, gridDim.x, blockIdx.x);
        EpiRes E{p.in[I_X], p.out, (bf16*)(ws + WS_XB), (float*)(ws + WS_SS2), rep_ == REPS(9) - 1};
        pg8::gemm_phase<EpiRes, SO, true>(ring, g, S, E, wave_s, vlane_id()); } SEAM(9);
    if (IN(10)) for (int rep_ = 0; rep_ < REPS(10); ++rep_) { pg8::Gemm g{(const bf16*)(ws + WS_XB), (const bf16*)(ws + WS_WUP), M, NUP, D, D, 256}; SO S; S.init(M, NUP, gridDim.x, blockIdx.x);
        EpiUpAct E{(bf16*)(ws + WS_U), (const float*)(ws + WS_SS2), p.in[I_CONVW], p.in[I_CONVB]};
        pg8::gemm_phase<EpiUpAct, SO, FUSE_ALIGN>(ring, g, S, E, wave_s, vlane_id()); } SEAM(10);
    if (IN(11)) for (int rep_ = 0; rep_ < REPS(11); ++rep_) { MKCTX phase5b_fix(p, c); } SEAM(11);
    if (IN(12)) for (int rep_ = 0; rep_ < REPS(12); ++rep_) { pg8::Gemm g{(const bf16*)(ws + WS_U) + 128, (const bf16*)(ws + WS_WDOWN), M, D, DFF, NUP, 512}; SO S; S.init(M, D, gridDim.x, blockIdx.x);
        EpiRes E{p.out, p.out, (bf16*)(ws + WS_XB), (float*)(ws + WS_SS3), rep_ == REPS(12) - 1};
        pg8::gemm_phase<EpiRes, SO, true>(ring, g, S, E, wave_s, vlane_id()); } SEAM(12);
    if (IN(13)) for (int rep_ = 0; rep_ < REPS(13); ++rep_) { pg8::Gemm g{(const bf16*)(ws + WS_PB), (const bf16*)(ws + WS_WPLE), M, D, PLED, PLED, 256}; SO S; S.init(M, D, gridDim.x, blockIdx.x);
        EpiPlain E{(bf16*)(ws + WS_PL), D};
        pg8::gemm_phase<EpiPlain, SO, true>(ring, g, S, E, wave_s, vlane_id()); } SEAM(13);
    if (IN(14)) for (int rep_ = 0; rep_ < REPS(14); ++rep_) { pg8::Gemm g{(const bf16*)(ws + WS_XB), (const bf16*)(ws + WS_WPG), M, D, D, D, 256}; SO S; S.init(M, D, gridDim.x, blockIdx.x);
        EpiFinal E{p.out, (const bf16*)(ws + WS_PL), (const float*)(ws + WS_SS3), p.in[I_BPG], (float*)(ws + WS_SSF), rep_ == REPS(14) - 1};
        pg8::gemm_phase<EpiFinal, SO, true>(ring, g, S, E, wave_s, vlane_id()); } SEAM(14);
    if (IN(15)) for (int rep_ = 0; rep_ < REPS(15); ++rep_) { MKCTX phase8(p, c, rep_ == REPS(15) - 1); }
#undef IN
#undef SEAM
}

#ifndef MK_PER_PHASE
#define MK_PER_PHASE 0
#endif
extern "C" void kernel_launch(void* const* d_in, const int* in_sizes, int n_in, void* d_out, int out_size, void* d_ws, size_t ws_size, hipStream_t stream) {
    static int grid = 0;
    if (grid == 0) {
        if (n_in != 30 || out_size != M * D || ws_size < WS_END) { fprintf(stderr, "kernel_launch: unexpected shapes (n_in %d out %d ws %zu)\n", n_in, out_size, ws_size); grid = -1; return; }
        int dev = 0, cus = 0, per_cu = 0;
        hipGetDevice(&dev); hipDeviceGetAttribute(&cus, hipDeviceAttributeMultiprocessorCount, dev);
        hipFuncSetAttribute((const void*)mk_fwd, hipFuncAttributeMaxDynamicSharedMemorySize, LDS_BYTES);
        hipOccupancyMaxActiveBlocksPerMultiprocessor(&per_cu, (const void*)mk_fwd, NTHR, LDS_BYTES);
        if (per_cu < 1) { fprintf(stderr, "kernel_launch: occupancy query says %d blocks/CU\n", per_cu); per_cu = 1; }
        grid = cus * (per_cu > 1 ? 1 : per_cu);
        if (grid > 256) grid = 256;
        if (grid != 256) { fprintf(stderr, "kernel_launch: this kernel is laid out for 256 co-resident workgroups; got %d\n", grid); grid = -1; return; }
        if ((M % (2 * grid * NWAVES)) != 0) { fprintf(stderr, "kernel_launch: grid %d does not divide the row count\n", grid); grid = -1; return; }
    }
    if (grid < 0) return;
    hipMemsetAsync(d_ws, 0, CTL_BYTES, stream);
    P p{};
    for (int i = 0; i < 30; ++i) p.in[i] = (const float*)d_in[i];
    p.out = (float*)d_out; p.ws = (unsigned char*)d_ws;
#if MK_PER_PHASE
    for (int k = 0; k < NPHASE; ++k) { p.ph_lo = k; p.ph_hi = k + 1; hipLaunchKernelGGL(mk_fwd, dim3(grid), dim3(NTHR), LDS_BYTES, stream, p); }
#else
    p.ph_lo = 0; p.ph_hi = NPHASE;
    void* args[] = {&p};
    hipError_t e = hipLaunchCooperativeKernel((const void*)mk_fwd, dim3(grid), dim3(NTHR), args, LDS_BYTES, stream);
    if (e != hipSuccess) fprintf(stderr, "cooperative launch failed: %s (grid %d)\n", hipGetErrorString(e), grid);
#endif
}
```

```cpp
#include <hip/hip_runtime.h>
#include <hip/hip_cooperative_groups.h>
#include <cstdio>
#include <cstdint>
namespace cg = cooperative_groups;

namespace pg8 {
#define PG8_LAS __attribute__((address_space(3)))
typedef unsigned short bf16_t;
typedef short bf16x8 __attribute__((ext_vector_type(8)));
typedef float f32x4 __attribute__((ext_vector_type(4)));
typedef unsigned u32x4 __attribute__((ext_vector_type(4)));
constexpr int BM = 256, BK = 64, HALF = 128, HTB = HALF * BK * 2  , STAGE_BYTES = 8 * HTB, NXCD = 8, WGM = 8;

__host__ __device__ __forceinline__ int lds_byte(int r, int c) { const int st = (r >> 4) * 2 + (c >> 5), rr = r & 15, cc = c & 31, ob = rr * 64 + cc * 2; return st * 1024 + (ob ^ (((ob >> 9) & 1) << 5)); }
__host__ __device__ __forceinline__ void stage_rc(int b, int& R, int& C) { const int st = b / 1024, sb = b % 1024, swz = sb ^ (((sb >> 9) & 1) << 5); R = (st >> 1) * 16 + swz / 64; C = (st & 1) * 32 + (swz % 64) / 2; }
__host__ __device__ __forceinline__ int perm32(int rho) { const int n = rho >> 4, i = rho & 15; return 8 * (i >> 2) + 4 * n + (i & 3); }

struct Unit { int pm, pn; };
struct Gemm { const bf16_t* A; const bf16_t* Bt; int M, N, K; int lda; int kpairA; };

struct StaticOrder {
    int nM, nN, nwg, G, c;
    __host__ __device__ void init(int M, int N, int G_, int c_) { nM = M / BM; nN = N / BM; nwg = nM * nN; G = G_; c = c_; }
    __host__ __device__ bool next(int i, Unit& u) const {
        const long L = (long)i * G + c; if (L >= nwg) return false;
        int wgid = (int)L; { const int q = nwg / NXCD, r = nwg % NXCD, xcd = wgid % NXCD, off = wgid / NXCD; wgid = (xcd < r ? xcd * (q + 1) : r * (q + 1) + (xcd - r) * q) + off; }
        const int nig = WGM * nN, gid = wgid / nig, fm = gid * WGM, gsz = (nM - fm) < WGM ? (nM - fm) : WGM;
        u.pm = fm + ((wgid % nig) % gsz); u.pn = (wgid % nig) / gsz; return true;
    }
};

__device__ __forceinline__ unsigned cvt_pk_bf16(float lo, float hi) { unsigned r; asm volatile("v_cvt_pk_bf16_f32 %0, %1, %2" : "=v"(r) : "v"(lo), "v"(hi)); return r; }
typedef float f32x2 __attribute__((ext_vector_type(2)));
__device__ __forceinline__ f32x2 gelu_pk(f32x2 v) {
    const f32x2 av = __builtin_elementwise_abs(v), d = av * 0.2316418882f + 1.0f;
    f32x2 t; t.x = __builtin_amdgcn_rcpf(d.x); t.y = __builtin_amdgcn_rcpf(d.y);
    f32x2 q = t * 0.5307027145f + (-0.7265760135f); q = q * t + 0.7107068705f; q = q * t + (-0.142248368f); q = q * t + 0.127414796f; q = q * t;
    const f32x2 s = (v * v) * (-0.72134752044f);
    f32x2 e; e.x = __builtin_amdgcn_exp2f(s.x); e.y = __builtin_amdgcn_exp2f(s.y);
    const f32x2 m = v * (q * e), r = v - m;
    f32x2 o; o.x = v.x < 0.f ? m.x : r.x; o.y = v.y < 0.f ? m.y : r.y; return o;
}

template <class Epi, class Sched, bool ALIGN_EPI>
__device__ __forceinline__ void gemm_phase(PG8_LAS unsigned char* lds, const Gemm g, const Sched& S, const Epi& E, int wid_in, int lane_in) {
    const int wid = __builtin_amdgcn_readfirstlane(wid_in), lane = lane_in, tid = wid * 64 + lane, wr = wid >> 2, wc = wid & 3, fr = lane & 15, fq = lane >> 4;
    const int K = g.K, nt = K / BK;
    unsigned voffA[2], voffB[2];
#pragma unroll
    for (int i = 0; i < 2; ++i) { int R, C; stage_rc(tid * 16 + i * 8192, R, C); const int Rb = (R & ~31) + perm32(R & 31);
        voffA[i] = (unsigned)(R * g.lda + C) * 2u; voffB[i] = (unsigned)(Rb * K + C) * 2u; }
    const size_t kstep = (size_t)(BK * 2);
    const size_t kpairA = (size_t)g.kpairA;
    const size_t hstepA = (size_t)HALF * g.lda * 2, hstepB = (size_t)HALF * K * 2;
    const size_t tstepA = 2 * hstepA, tstepB = 2 * hstepB;
    const unsigned ldsw = (unsigned)wid * 1024u;
    const int aoff = lds_byte(wr * 64 + fr, fq * 8), boff = lds_byte(wc * 32 + fr, fq * 8);
#define PG8_SA(b, h) (((b) * 2 + (h)) * HTB)
#define PG8_SB(b, h) ((4 + (b) * 2 + (h)) * HTB)
#define PG8_STAGE(bufoff, gbase, voff) do { _Pragma("unroll") for (int _i = 0; _i < 2; ++_i) \
        __builtin_amdgcn_global_load_lds((const unsigned*)((const char*)(gbase) + (voff)[_i]), (PG8_LAS unsigned*)(lds + (bufoff) + ldsw + _i * 8192), 16, 0, 0); } while (0)
#define PG8_LDA(dst, b, h) do { _Pragma("unroll") for (int m = 0; m < 4; ++m) _Pragma("unroll") for (int k = 0; k < 2; ++k) dst[m][k] = *(const PG8_LAS bf16x8*)(lds + PG8_SA(b, h) + aoff + m * 2048 + k * 1024); } while (0)
#define PG8_LDB(dst, b, h) do { _Pragma("unroll") for (int n = 0; n < 2; ++n) _Pragma("unroll") for (int k = 0; k < 2; ++k) dst[n][k] = *(const PG8_LAS bf16x8*)(lds + PG8_SB(b, h) + boff + n * 2048 + k * 1024); } while (0)
#define PG8_MMA(ai, bj, At, Bt) do { __builtin_amdgcn_s_setprio(1); _Pragma("unroll") for (int m = 0; m < 4; ++m) _Pragma("unroll") for (int n = 0; n < 2; ++n) _Pragma("unroll") for (int k = 0; k < 2; ++k) \
        acc[ai][bj][m][n] = __builtin_amdgcn_mfma_f32_16x16x32_bf16(Bt[n][k], At[m][k], acc[ai][bj][m][n], 0, 0, 0); __builtin_amdgcn_s_setprio(0); } while (0)
#define PG8_WAIT_V(n) asm volatile("s_waitcnt vmcnt(" #n ")" ::: "memory")
#define PG8_WAIT_L(n) asm volatile("s_waitcnt lgkmcnt(" #n ")" ::: "memory")
#define PG8_BAR __builtin_amdgcn_s_barrier()
#define PG8_SCHED __builtin_amdgcn_sched_barrier(0)
    Unit cur, nxt; int ui = 0;
    if (!S.next(0, cur)) return;
    f32x4 acc[2][2][4][2];
#pragma unroll
    for (int a = 0; a < 2; ++a)
#pragma unroll
        for (int b = 0; b < 2; ++b)
#pragma unroll
            for (int m = 0; m < 4; ++m)
#pragma unroll
                for (int n = 0; n < 2; ++n) acc[a][b][m][n] = (f32x4){0.f, 0.f, 0.f, 0.f};
    bf16x8 At[4][2], B0[2][2], B1[2][2];
    const char* cA = (const char*)g.A + (size_t)cur.pm * tstepA; const char* cB = (const char*)g.Bt + (size_t)cur.pn * tstepB;
    PG8_STAGE(PG8_SB(0, 0), cB, voffB); PG8_STAGE(PG8_SB(0, 1), cB + hstepB, voffB); PG8_STAGE(PG8_SA(0, 0), cA, voffA); PG8_STAGE(PG8_SA(0, 1), cA + hstepA, voffA);
    if (wr == 1) PG8_BAR;
    PG8_WAIT_V(2); PG8_BAR;
    PG8_STAGE(PG8_SB(1, 0), cB + kstep, voffB); PG8_STAGE(PG8_SA(1, 0), cA + kstep, voffA); PG8_STAGE(PG8_SB(1, 1), cB + hstepB + kstep, voffB);
    PG8_WAIT_V(6); PG8_BAR;
    for (;;) {
        const bool has_next = S.next(ui + 1, nxt);
        const char* nA = has_next ? (const char*)g.A + (size_t)nxt.pm * tstepA : cA; const char* nB = has_next ? (const char*)g.Bt + (size_t)nxt.pn * tstepB : cB;
#pragma unroll 1
        for (int t = 0; t < nt; t += 2) {
            if constexpr (Epi::MID) { if (t == (nt >> 1)) E.mid(acc, cur, wr, wc, fr, fq); }
            const bool last = (t == nt - 2);
            const char* a1 = cA + (size_t)(t >> 1) * kpairA + kstep;
            const char* a2 = last ? nA : cA + (size_t)((t >> 1) + 1) * kpairA; const char* b2 = last ? nB : cB + (size_t)(t + 2) * kstep;
            const char* a3 = a2 + kstep; const char* b3 = b2 + kstep;
            PG8_LDB(B0, 0, 0); PG8_LDB(B1, 0, 1); PG8_SCHED; PG8_LDA(At, 0, 0); PG8_STAGE(PG8_SA(1, 1), a1 + hstepA, voffA);
            PG8_WAIT_V(8); PG8_WAIT_L(0); PG8_BAR; PG8_MMA(0, 0, At, B0); PG8_MMA(0, 1, At, B1); PG8_BAR; PG8_SCHED;
            PG8_LDA(At, 0, 1); PG8_STAGE(PG8_SB(0, 0), b2, voffB); PG8_STAGE(PG8_SB(0, 1), b2 + hstepB, voffB); PG8_STAGE(PG8_SA(0, 0), a2, voffA);
            PG8_WAIT_V(8); PG8_WAIT_L(0); PG8_BAR; PG8_MMA(1, 0, At, B0); PG8_MMA(1, 1, At, B1); PG8_BAR; PG8_SCHED;
            PG8_LDB(B0, 1, 0); PG8_LDB(B1, 1, 1); PG8_SCHED; PG8_LDA(At, 1, 0); PG8_STAGE(PG8_SA(0, 1), a2 + hstepA, voffA);
            PG8_WAIT_V(8); PG8_WAIT_L(0); PG8_BAR; PG8_MMA(0, 0, At, B0); PG8_MMA(0, 1, At, B1); PG8_BAR; PG8_SCHED;
            PG8_LDA(At, 1, 1); PG8_STAGE(PG8_SB(1, 0), b3, voffB); PG8_STAGE(PG8_SB(1, 1), b3 + hstepB, voffB); PG8_STAGE(PG8_SA(1, 0), a3, voffA);
            PG8_WAIT_V(8); PG8_WAIT_L(0); PG8_BAR; PG8_MMA(1, 0, At, B0); PG8_MMA(1, 1, At, B1); PG8_BAR; PG8_SCHED;
        }
        if constexpr (ALIGN_EPI) { if (wr == 0) PG8_BAR; }
        E(acc, cur, wr, wc, fr, fq);
        if (!has_next) break;
#pragma unroll
        for (int a = 0; a < 2; ++a)
#pragma unroll
            for (int b = 0; b < 2; ++b)
#pragma unroll
                for (int m = 0; m < 4; ++m)
#pragma unroll
                    for (int n = 0; n < 2; ++n) acc[a][b][m][n] = (f32x4){0.f, 0.f, 0.f, 0.f};
        cur = nxt; cA = nA; cB = nB; ++ui;
        if constexpr (ALIGN_EPI) { if (wr == 1) PG8_BAR; }
    }
    PG8_WAIT_V(0);
    if constexpr (!ALIGN_EPI) { if (wr == 0) PG8_BAR; }
    PG8_BAR;
#undef PG8_SA
#undef PG8_SB
#undef PG8_STAGE
#undef PG8_LDA
#undef PG8_LDB
#undef PG8_MMA
#undef PG8_WAIT_V
#undef PG8_WAIT_L
#undef PG8_BAR
#undef PG8_SCHED
}
}

typedef unsigned short bf16;
typedef short bf16x8 __attribute__((ext_vector_type(8)));
typedef float f32x4 __attribute__((ext_vector_type(4)));
typedef float f32x16 __attribute__((ext_vector_type(16)));
typedef float f32x2 __attribute__((ext_vector_type(2)));
typedef __bf16 bf16x2v __attribute__((ext_vector_type(2)));
typedef unsigned u32x4 __attribute__((ext_vector_type(4)));
typedef unsigned u32x2 __attribute__((ext_vector_type(2)));
typedef _Float16 h4 __attribute__((ext_vector_type(4)));

constexpr int NB = 8, T = 4096, D = 1024, M = NB * T, NH = 8;
constexpr int ZMAIN = 3328, NGATE = 2048, DFF = 2816, NUP = 5632, PLED = 256;
constexpr float NORM_EPS = 1e-6f, GN_EPS = 64e-5f, LOG2E = 1.4426950408889634f, QSCALE = 0.125f * 1.4426950408889634f;
constexpr int NWAVES = 8, NTHR = 512;
constexpr int LDS_BYTES = 147456;
constexpr int REC = 768;

constexpr size_t MiB = (size_t)1 << 20;
constexpr size_t WS_SS2 = 0, WS_SS3 = 128 * 1024, WS_SSF = 256 * 1024, WS_BAR = 512 * 1024, WS_BT2 = 1 * MiB, CTL_BYTES = 2 * MiB;
constexpr size_t WS_WIN = 2 * MiB, WS_WUP = 13 * MiB, WS_WDOWN = 24 * MiB, WS_WO = 30 * MiB, WS_WBR = 32 * MiB, WS_WPG = 34 * MiB, WS_WPLE = 36 * MiB;
constexpr size_t WS_PB = 37 * MiB, WS_XB = 53 * MiB;
constexpr size_t WS_ZRM = 117 * MiB, WS_OAB = 117 * MiB, WS_U = 117 * MiB, WS_PL = 117 * MiB, WS_X3 = 181 * MiB;
constexpr size_t WS_QK = 213 * MiB, WS_GATES = 213 * MiB, WS_MERGED = 341 * MiB;
constexpr size_t WS_PACK = 277 * MiB, WS_V = 277 * MiB, WS_ZLOW = 309 * MiB;
constexpr size_t WS_BONUS = 501 * MiB, WS_END = 512 * MiB;
constexpr size_t O_A = 0, O_G = 32 * MiB, O_VT = 64 * MiB, O_Y = 96 * MiB, O_A2 = 96 * MiB;

__device__ __forceinline__ unsigned f2bf(float f) { unsigned u = __builtin_bit_cast(unsigned, f); return (u + 0x7fffu + ((u >> 16) & 1u)) >> 16; }
__device__ __forceinline__ unsigned pk2(float lo, float hi) { return f2bf(lo) | (f2bf(hi) << 16); }
__device__ __forceinline__ float bf2f(unsigned b) { return __builtin_bit_cast(float, b << 16); }
__device__ __forceinline__ float bflo(unsigned w) { return __builtin_bit_cast(float, w << 16); }
__device__ __forceinline__ float bfhi(unsigned w) { return __builtin_bit_cast(float, w & 0xffff0000u); }
__device__ __forceinline__ unsigned cvtpk(float lo, float hi) { f32x2 v = {lo, hi}; bf16x2v b = __builtin_convertvector(v, bf16x2v); return __builtin_bit_cast(unsigned, b); }
__device__ __forceinline__ unsigned short f2h(float f) { _Float16 h = (_Float16)f; return __builtin_bit_cast(unsigned short, h); }
__device__ __forceinline__ float wave_sum(float v) {
#pragma unroll
    for (int o = 1; o < 64; o <<= 1) v += __shfl_xor(v, o);
    return v;
}
__device__ __forceinline__ float sigmoidf_(float x) { return 1.f / (1.f + __expf(-x)); }
template <int CTRL> __device__ __forceinline__ float dpp_add(float x) { return x + __builtin_bit_cast(float, __builtin_amdgcn_update_dpp(0, __builtin_bit_cast(int, x), CTRL, 0xF, 0xF, true)); }
__device__ __forceinline__ float allreduce16(float x) { x = dpp_add<0xB1>(x); x = dpp_add<0x4E>(x); x = dpp_add<0x141>(x); x = dpp_add<0x140>(x); return x; }
#define MFMA32(a, b, c) __builtin_amdgcn_mfma_f32_32x32x16_bf16((a), (b), (c), 0, 0, 0)
__device__ __forceinline__ bf16x8 packstep(const f32x16& x, int s) {
    u32x4 w; w[0] = cvtpk(x[8 * s], x[8 * s + 1]); w[1] = cvtpk(x[8 * s + 2], x[8 * s + 3]); w[2] = cvtpk(x[8 * s + 4], x[8 * s + 5]); w[3] = cvtpk(x[8 * s + 6], x[8 * s + 7]);
    return __builtin_bit_cast(bf16x8, w);
}

using pg8::Unit; using pg8::cvt_pk_bf16;
#define EPI_TRAITS(mid) static constexpr bool PERM = true, AFTER_DRAIN = false, MID = mid;
#define EPI_ARGS const f32x4 (&acc)[2][2][4][2], const Unit& u, int wr, int wc, int fr, int fq
__device__ __forceinline__ u32x4 pack8(f32x4 v0, f32x4 v1) { u32x4 w; w.x = cvt_pk_bf16(v0[0], v0[1]); w.y = cvt_pk_bf16(v0[2], v0[3]); w.z = cvt_pk_bf16(v1[0], v1[1]); w.w = cvt_pk_bf16(v1[2], v1[3]); return w; }
__device__ __forceinline__ void unpack8(u32x4 w, f32x4& v0, f32x4& v1) { v0 = (f32x4){bflo(w.x), bfhi(w.x), bflo(w.y), bfhi(w.y)}; v1 = (f32x4){bflo(w.z), bfhi(w.z), bflo(w.w), bfhi(w.w)}; }

struct EpiZ { EPI_TRAITS(false)
    bf16 *ZRM, *ZLOW, *QK, *V;
    __device__ __forceinline__ void operator()(EPI_ARGS) const {
        const int colt = u.pn * 256; bf16* base; int ldc, c0; float sc = 1.f;
        if (colt < 1536) { base = ZRM; ldc = 1536; c0 = colt; }
        else if (colt < 1792) { base = ZLOW; ldc = 256; c0 = 0; }
        else if (colt < 2816) { base = QK; ldc = 1024; c0 = colt - 1792; if (c0 < 512) sc = QSCALE; }
        else { base = V; ldc = 512; c0 = colt - 2816; }
        const int col0 = c0 + wc * 32 + 8 * fq, row0 = u.pm * 256 + wr * 64 + fr;
#pragma unroll
        for (int ai = 0; ai < 2; ++ai)
#pragma unroll
            for (int m = 0; m < 4; ++m) { bf16* rowp = base + (size_t)(row0 + ai * 128 + m * 16) * ldc + col0;
#pragma unroll
                for (int bj = 0; bj < 2; ++bj) *(u32x4*)(rowp + bj * 128) = pack8(acc[ai][bj][m][0] * sc, acc[ai][bj][m][1] * sc); }
    }
};
struct EpiVT { EPI_TRAITS(false)
    bf16* VT;
    __device__ __forceinline__ void operator()(EPI_ARGS) const {
        const int col0 = u.pn * 256 + wc * 32 + 8 * fq, row0 = u.pm * 256 + wr * 64 + fr;
#pragma unroll
        for (int ai = 0; ai < 2; ++ai)
#pragma unroll
            for (int m = 0; m < 4; ++m) { const int r = row0 + ai * 128 + m * 16;
#pragma unroll
                for (int bj = 0; bj < 2; ++bj) { const int cc = col0 + bj * 128, b = cc / T, t = cc % T;
                    *(u32x4*)(VT + ((size_t)(b * 512 + r)) * T + t) = pack8(acc[ai][bj][m][0], acc[ai][bj][m][1]); } }
    }
};
struct EpiPlain { EPI_TRAITS(false)
    bf16* O; int ldc;
    __device__ __forceinline__ void operator()(EPI_ARGS) const {
        const int col0 = u.pn * 256 + wc * 32 + 8 * fq, row0 = u.pm * 256 + wr * 64 + fr;
#pragma unroll
        for (int ai = 0; ai < 2; ++ai)
#pragma unroll
            for (int m = 0; m < 4; ++m) { bf16* rowp = O + (size_t)(row0 + ai * 128 + m * 16) * ldc + col0;
#pragma unroll
                for (int bj = 0; bj < 2; ++bj) *(u32x4*)(rowp + bj * 128) = pack8(acc[ai][bj][m][0], acc[ai][bj][m][1]); }
    }
};
struct EpiLR { EPI_TRAITS(false)
    unsigned char* PACK; bf16* Aout; bf16* Gout; const float* w0; const float* a0;
    __device__ __forceinline__ void operator()(EPI_ARGS) const {
        const int colt = u.pn * 256, region = colt >> 9; const int row0 = u.pm * 256 + wr * 64 + fr;
#pragma unroll
        for (int bj = 0; bj < 2; ++bj) {
            const int c = (colt & 511) + bj * 128 + wc * 32 + 8 * fq;
            f32x4 p0 = {0.f, 0.f, 0.f, 0.f}, p1 = p0;
            if (region == 0) { p0 = *(const f32x4*)(w0 + c); p1 = *(const f32x4*)(w0 + c + 4); }
            else if (region == 1) { p0 = *(const f32x4*)(a0 + c); p1 = *(const f32x4*)(a0 + c + 4); }
#pragma unroll
            for (int ai = 0; ai < 2; ++ai)
#pragma unroll
                for (int m = 0; m < 4; ++m) {
                    const int row = row0 + ai * 128 + m * 16;
                    f32x4 v0 = acc[ai][bj][m][0] + p0, v1 = acc[ai][bj][m][1] + p1;
                    if (region == 0) {
#pragma unroll
                        for (int e = 0; e < 4; ++e) { v0[e] = __expf(-0.6065306597126334f * sigmoidf_(v0[e])); v1[e] = __expf(-0.6065306597126334f * sigmoidf_(v1[e])); }
                        const int b = row / T, t = row % T, h = c >> 6;
                        unsigned short* dst = (unsigned short*)(PACK + ((size_t)((b * NH + h) * T + t)) * REC + 640) + (c & 63);
                        u32x4 w_; w_.x = (unsigned)f2h(v0[0] - 1.f) | ((unsigned)f2h(v0[1] - 1.f) << 16); w_.y = (unsigned)f2h(v0[2] - 1.f) | ((unsigned)f2h(v0[3] - 1.f) << 16);
                        w_.z = (unsigned)f2h(v1[0] - 1.f) | ((unsigned)f2h(v1[1] - 1.f) << 16); w_.w = (unsigned)f2h(v1[2] - 1.f) | ((unsigned)f2h(v1[3] - 1.f) << 16);
                        *(u32x4*)dst = w_;
                    } else if (region == 1) {
#pragma unroll
                        for (int e = 0; e < 4; ++e) { v0[e] = sigmoidf_(v0[e]); v1[e] = sigmoidf_(v1[e]); }
                        *(u32x4*)(Aout + (size_t)row * 512 + c) = pack8(v0, v1);
                    } else {
                        *(u32x4*)(Gout + (size_t)row * 512 + c) = pack8(v0, v1);
                    }
                }
        }
    }
};
struct EpiGate { EPI_TRAITS(false)
    bf16* O; const float* bias;
    __device__ __forceinline__ void operator()(EPI_ARGS) const {
        const int ch0 = u.pn * 128 + wc * 32 + 8 * fq, colr = u.pn * 256 + wc * 32 + 8 * fq, row0 = u.pm * 256 + wr * 64 + fr;
        const f32x4 ba0 = *(const f32x4*)(bias + ch0), ba1 = *(const f32x4*)(bias + ch0 + 4), bb0 = *(const f32x4*)(bias + 1024 + ch0), bb1 = *(const f32x4*)(bias + 1024 + ch0 + 4);
#pragma unroll
        for (int ai = 0; ai < 2; ++ai)
#pragma unroll
            for (int m = 0; m < 4; ++m) {
                f32x4 a0 = acc[ai][0][m][0] + ba0, a1 = acc[ai][0][m][1] + ba1, b0 = acc[ai][1][m][0] + bb0, b1 = acc[ai][1][m][1] + bb1;
#pragma unroll
                for (int e = 0; e < 4; ++e) { b0[e] = fmaxf(sigmoidf_(b0[e]), 1e-30f); b1[e] = fmaxf(sigmoidf_(b1[e]), 1e-30f);
                    a0[e] = sigmoidf_(a0[e]) * __builtin_amdgcn_rcpf(b0[e]); a1[e] = sigmoidf_(a1[e]) * __builtin_amdgcn_rcpf(b1[e]); }
                bf16* rowp = O + (size_t)(row0 + ai * 128 + m * 16) * NGATE + colr;
                *(u32x4*)rowp = pack8(a0, a1); *(u32x4*)(rowp + 128) = pack8(b0, b1);
            }
    }
};
struct EpiMerge { EPI_TRAITS(true)
    const bf16* GATES; bf16* O;
    __device__ __forceinline__ void mid(f32x4 (&acc)[2][2][4][2], const Unit& u, int wr, int wc, int fr, int fq) const {
        const int gcol = u.pn * 512 + wc * 32 + 8 * fq, row0 = u.pm * 256 + wr * 64 + fr;
#pragma unroll
        for (int ai = 0; ai < 2; ++ai) {
            u32x4 gr[4][2];
#pragma unroll
            for (int m = 0; m < 4; ++m) {
                int row_ = row0 + ai * 128 + m * 16; asm volatile("" : "+v"(row_));
#pragma unroll
                for (int bj = 0; bj < 2; ++bj) gr[m][bj] = *(const u32x4*)(GATES + (size_t)row_ * NGATE + gcol + bj * 256);
            }
            __builtin_amdgcn_sched_barrier(0);
#pragma unroll
            for (int m = 0; m < 4; ++m)
#pragma unroll
                for (int bj = 0; bj < 2; ++bj) { f32x4 r0, r1; unpack8(gr[m][bj], r0, r1); acc[ai][bj][m][0] *= r0; acc[ai][bj][m][1] *= r1; }
            __builtin_amdgcn_sched_barrier(0);
        }
    }
    __device__ __forceinline__ void operator()(EPI_ARGS) const {
        const int col0 = u.pn * 256 + wc * 32 + 8 * fq, gcol = u.pn * 512 + wc * 32 + 8 * fq + 128, row0 = u.pm * 256 + wr * 64 + fr;
#pragma unroll
        for (int ai = 0; ai < 2; ++ai)
#pragma unroll
            for (int m = 0; m < 4; ++m)
#pragma unroll
                for (int bj = 0; bj < 2; ++bj) {
                    int row_ = row0 + ai * 128 + m * 16; asm volatile("" : "+v"(row_)); const size_t row = (size_t)row_;
                    f32x4 b0, b1; unpack8(*(const u32x4*)(GATES + row * NGATE + gcol + bj * 256), b0, b1);
                    *(u32x4*)(O + row * D + col0 + bj * 128) = pack8(acc[ai][bj][m][0] * b0, acc[ai][bj][m][1] * b1);
                    if (bj == 1 && (m & 1)) __builtin_amdgcn_sched_barrier(0);
                }
    }
};
struct EpiRes { EPI_TRAITS(false)
    const float* base; bf16* XB; float* SS; int dost;
    __device__ __forceinline__ void operator()(EPI_ARGS) const {
        const int col0 = u.pn * 256 + wc * 32 + 8 * fq, row0 = u.pm * 256 + wr * 64 + fr;
#pragma unroll
        for (int ai = 0; ai < 2; ++ai)
#pragma unroll
            for (int m = 0; m < 4; ++m) {
                const size_t row = (size_t)(row0 + ai * 128 + m * 16); float ss = 0.f;
#pragma unroll
                for (int bj = 0; bj < 2; ++bj) {
                    const size_t o = row * D + col0 + bj * 128;
                    f32x4 v0 = *(const f32x4*)(base + o) + acc[ai][bj][m][0], v1 = *(const f32x4*)(base + o + 4) + acc[ai][bj][m][1];
                    if (dost) *(u32x4*)(XB + o) = pack8(v0, v1);
#pragma unroll
                    for (int e = 0; e < 4; ++e) ss += v0[e] * v0[e] + v1[e] * v1[e];
                }
                ss += __shfl_xor(ss, 16); ss += __shfl_xor(ss, 32);
                if (fq == 0 && dost) atomicAdd(SS + row, ss);
            }
    }
};
struct EpiResB { EPI_TRAITS(false)
    bf16* XB; float* SS; int dost;
    __device__ __forceinline__ void operator()(EPI_ARGS) const {
        const int col0 = u.pn * 256 + wc * 32 + 8 * fq, row0 = u.pm * 256 + wr * 64 + fr;
#pragma unroll
        for (int ai = 0; ai < 2; ++ai)
#pragma unroll
            for (int m = 0; m < 4; ++m) {
                const size_t row = (size_t)(row0 + ai * 128 + m * 16); float ss = 0.f;
#pragma unroll
                for (int bj = 0; bj < 2; ++bj) {
                    const size_t o = row * D + col0 + bj * 128;
                    f32x4 b0, b1; unpack8(*(const u32x4*)(XB + o), b0, b1);
                    f32x4 v0 = b0 + acc[ai][bj][m][0], v1 = b1 + acc[ai][bj][m][1];
                    if (dost) *(u32x4*)(XB + o) = pack8(v0, v1);
#pragma unroll
                    for (int e = 0; e < 4; ++e) ss += v0[e] * v0[e] + v1[e] * v1[e];
                }
                ss += __shfl_xor(ss, 16); ss += __shfl_xor(ss, 32);
                if (fq == 0 && dost) atomicAdd(SS + row, ss);
            }
    }
};
struct EpiUp { EPI_TRAITS(false)
    bf16* O; const float* SS;
    __device__ __forceinline__ void operator()(EPI_ARGS) const {
        const int col0 = u.pn * 256 + wc * 32 + 8 * fq, row0 = u.pm * 256 + wr * 64 + fr;
#pragma unroll
        for (int ai = 0; ai < 2; ++ai)
#pragma unroll
            for (int m = 0; m < 4; ++m) {
                const size_t row = (size_t)(row0 + ai * 128 + m * 16); const float rs = rsqrtf(SS[row] * (1.f / D) + NORM_EPS);
#pragma unroll
                for (int bj = 0; bj < 2; ++bj) *(u32x4*)(O + row * NUP + col0 + bj * 128) = pack8(acc[ai][bj][m][0] * rs, acc[ai][bj][m][1] * rs);
            }
    }
};
template <int CTRL> __device__ __forceinline__ float dpp_mov_f(float oldv, float x) { return __builtin_bit_cast(float, __builtin_amdgcn_update_dpp(__builtin_bit_cast(int, oldv), __builtin_bit_cast(int, x), CTRL, 0xF, 0xF, false)); }
struct EpiUpAct { EPI_TRAITS(false)
    bf16* O; const float* SS; const float* cw; const float* cb;
    __device__ __forceinline__ void operator()(EPI_ARGS) const {
        const int colb = u.pn * 256 + wc * 32 + 8 * fq, ch0 = u.pn * 128 + wc * 32 + 8 * fq, row0 = u.pm * 256 + wr * 64 + fr;
        f32x4 W0[2], W1[2], W2[2], CB[2];
#pragma unroll
        for (int n = 0; n < 2; ++n) { W0[n] = *(const f32x4*)(cw + ch0 + 4 * n); W1[n] = *(const f32x4*)(cw + DFF + ch0 + 4 * n); W2[n] = *(const f32x4*)(cw + 2 * DFF + ch0 + 4 * n); CB[n] = *(const f32x4*)(cb + ch0 + 4 * n); }
#pragma unroll
        for (int ai = 0; ai < 2; ++ai) {
            f32x4 pv[2] = {{0.f, 0.f, 0.f, 0.f}, {0.f, 0.f, 0.f, 0.f}};
#pragma unroll
            for (int m = 0; m < 4; ++m) {
                int row_ = row0 + ai * 128 + m * 16; asm volatile("" : "+v"(row_)); const size_t row = (size_t)row_;
                const float rs = rsqrtf(SS[row] * (1.f / D) + NORM_EPS);
                f32x4 cur[2] = {acc[ai][0][m][0] * rs, acc[ai][0][m][1] * rs}, gv[2] = {acc[ai][1][m][0] * rs, acc[ai][1][m][1] * rs}, r[2];
#pragma unroll
                for (int n = 0; n < 2; ++n)
#pragma unroll
                    for (int e = 0; e < 4; e += 2) {
                        f32x2 cv;
                        { const float c_ = cur[n][e], p_ = pv[n][e]; const float p1 = dpp_mov_f<0x111>(dpp_mov_f<0x121>(0.f, p_), c_), p2 = dpp_mov_f<0x112>(dpp_mov_f<0x122>(0.f, p_), c_);
                          cv.x = CB[n][e] + W0[n][e] * p2 + W1[n][e] * p1 + W2[n][e] * c_; }
                        { const float c_ = cur[n][e + 1], p_ = pv[n][e + 1]; const float p1 = dpp_mov_f<0x111>(dpp_mov_f<0x121>(0.f, p_), c_), p2 = dpp_mov_f<0x112>(dpp_mov_f<0x122>(0.f, p_), c_);
                          cv.y = CB[n][e + 1] + W0[n][e + 1] * p2 + W1[n][e + 1] * p1 + W2[n][e + 1] * c_; }
                        const f32x2 ge = pg8::gelu_pk(cv); r[n][e] = ge.x * gv[n][e]; r[n][e + 1] = ge.y * gv[n][e + 1];
                    }
                const bool rawrow = (m == 0) && (fr < 2);
                if ((m == 0 && fr < 2) || (m == 3 && fr >= 14)) { const int rl = row_ & 63, slot = 4 * (row_ >> 6) + (rl < 2 ? rl : rl - 60);
                    *(u32x4*)(O + (size_t)M * DFF + (size_t)slot * DFF + ch0) = pack8(cur[0], cur[1]); }
                *(u32x4*)(O + row * DFF + ch0) = rawrow ? pack8(gv[0], gv[1]) : pack8(r[0], r[1]);
                pv[0] = cur[0]; pv[1] = cur[1];
                __builtin_amdgcn_sched_barrier(0);
            }
        }
    }
};
struct EpiFinal { EPI_TRAITS(false)
    bf16* X3; const bf16* XB; const bf16* PL; const float* SS3; const float* bias; float* SSF; int dost;
    __device__ __forceinline__ void operator()(EPI_ARGS) const {
        const int col0 = u.pn * 256 + wc * 32 + 8 * fq, row0 = u.pm * 256 + wr * 64 + fr;
        f32x4 bb[2][2];
#pragma unroll
        for (int bj = 0; bj < 2; ++bj) { bb[bj][0] = *(const f32x4*)(bias + col0 + bj * 128); bb[bj][1] = *(const f32x4*)(bias + col0 + bj * 128 + 4); }
#pragma unroll
        for (int ai = 0; ai < 2; ++ai)
#pragma unroll
            for (int m = 0; m < 4; ++m) {
                const size_t row = (size_t)(row0 + ai * 128 + m * 16); const float rs = rsqrtf(SS3[row] * (1.f / D) + NORM_EPS); float ss = 0.f;
#pragma unroll
                for (int bj = 0; bj < 2; ++bj) {
                    const size_t o = row * D + col0 + bj * 128;
                    f32x4 p0, p1; unpack8(*(const u32x4*)(PL + o), p0, p1);
                    f32x4 g0 = acc[ai][bj][m][0] * rs + bb[bj][0], g1 = acc[ai][bj][m][1] * rs + bb[bj][1];
#pragma unroll
                    for (int e = 0; e < 4; ++e) { g0[e] = sigmoidf_(g0[e]); g1[e] = sigmoidf_(g1[e]); }
                    f32x4 x0, x1; unpack8(*(const u32x4*)(XB + o), x0, x1);
                    f32x4 v0 = x0 + p0 * g0, v1 = x1 + p1 * g1;
                    if (dost) *(u32x4*)(X3 + o) = pack8(v0, v1);
#pragma unroll
                    for (int e = 0; e < 4; ++e) ss += v0[e] * v0[e] + v1[e] * v1[e];
                }
                ss += __shfl_xor(ss, 16); ss += __shfl_xor(ss, 32);
                if (fq == 0 && dost) atomicAdd(SSF + row, ss);
            }
    }
};

#define XB_TMO      128
#define XB_XCNT(j)  (256  + 64 * (j))
#define XB_XSUB(j)  (1280 + 64 * (j))
#define XB_XGEN(j)  (2304 + 64 * (j))
#define XB_TOP      3328
#define XB_TOPGEN   3392
#define XCD_BAR_WORDS 3456
#define XB_SPIN_CAP (1u << 18)

__device__ __forceinline__ unsigned xb_ld(unsigned* p)              { return __hip_atomic_load(p, __ATOMIC_RELAXED, __HIP_MEMORY_SCOPE_AGENT); }
__device__ __forceinline__ unsigned xb_add(unsigned* p, unsigned v) { return __hip_atomic_fetch_add(p, v, __ATOMIC_RELAXED, __HIP_MEMORY_SCOPE_AGENT); }
__device__ __forceinline__ unsigned xb_xcc_id() { return (unsigned)__builtin_amdgcn_s_getreg((3 << 11) | 20) & 0xFu; }
#define XB_SPIN(cond, bar) do { unsigned _sp = 0; while (cond) { __builtin_amdgcn_s_sleep(1); \
    if ((++_sp & 255u) == 0u) { if (xb_ld(&(bar)[XB_TMO])) break; if (_sp > XB_SPIN_CAP) { atomicAdd(&(bar)[XB_TMO], 1u); break; } } } } while (0)

struct XcdBarrier {
    unsigned* bar; unsigned x;
    volatile __attribute__((address_space(3))) unsigned* st;
};

__device__ __forceinline__ XcdBarrier xcd_barrier_post(unsigned* bar, volatile __attribute__((address_space(3))) unsigned* st) {
    XcdBarrier b; b.bar = bar; b.x = xb_xcc_id(); b.st = st;
    if (threadIdx.x == 0) (void)xb_add(&bar[XB_XCNT(b.x)], 1u);
    return b;
}
__device__ __forceinline__ void xcd_barrier_complete(unsigned* bar, unsigned x, unsigned& nloc, unsigned& nx) {
    const unsigned G = gridDim.x * gridDim.y * gridDim.z;
    unsigned sum, cnt, mine, sp = 0u;
    for (;;) {
        sum = 0u; cnt = 0u; mine = 0u;
#pragma unroll
        for (unsigned j = 0; j < 16; ++j) { const unsigned c = xb_ld(&bar[XB_XCNT(j)]); sum += c; cnt += (c > 0u) ? 1u : 0u; mine = (j == x) ? c : mine; }
        if (sum == G) break;
        __builtin_amdgcn_s_sleep(1);
        if ((++sp & 255u) == 0u) { if (xb_ld(&bar[XB_TMO])) break; if (sp > XB_SPIN_CAP) { atomicAdd(&bar[XB_TMO], 1u); break; } }
    }
    nloc = mine > 0u ? mine : 1u; nx = cnt > 0u ? cnt : 1u;
}

__device__ __forceinline__ void xcd_barrier(const XcdBarrier& b, int tid_) {
    asm volatile("s_waitcnt vmcnt(0)" ::: "memory");
    __syncthreads();
    if (tid_ == 0) {
        unsigned* bar = b.bar;
        __builtin_amdgcn_s_waitcnt(0);
        unsigned nloc = b.st[0], nx = b.st[1];
        if (nloc == 0u) { xcd_barrier_complete(bar, b.x, nloc, nx); b.st[0] = nloc; b.st[1] = nx; }
        const unsigned old = xb_add(&bar[XB_XSUB(b.x)], 1u);
        const unsigned gen = old / nloc;
        if (old + 1u == (gen + 1u) * nloc) {
            __builtin_amdgcn_fence(__ATOMIC_RELEASE, "agent");
            asm volatile("s_waitcnt vmcnt(0)" ::: "memory");
            const unsigned og = xb_add(&bar[XB_TOP], 1u);
            const unsigned tg = og / nx;
            if (og + 1u == (tg + 1u) * nx) xb_add(&bar[XB_TOPGEN], 1u);
            else XB_SPIN(xb_ld(&bar[XB_TOPGEN]) == tg, bar);
            __builtin_amdgcn_fence(__ATOMIC_ACQUIRE, "agent");
            xb_add(&bar[XB_XGEN(b.x)], 1u);
            asm volatile("s_waitcnt vmcnt(0)" ::: "memory");
        } else {
            XB_SPIN(xb_ld(&bar[XB_XGEN(b.x)]) == gen, bar);
            __builtin_amdgcn_fence(__ATOMIC_ACQUIRE, "agent");
            asm volatile("s_waitcnt vmcnt(0)" ::: "memory");
        }
    }
    __syncthreads();
}

struct Ctx { unsigned char* lds; int tid, lane, wave, G, gw, NGW; };
__device__ __forceinline__ int vlane_id() { int l; asm volatile("v_mbcnt_lo_u32_b32 %0, -1, 0\n\tv_mbcnt_hi_u32_b32 %0, -1, %0" : "=v"(l)); return l; }

template <int KT>
__device__ __forceinline__ void p0_transpose_item(const float* W, int K, int N, bf16* WT, int ldk, int koff, int row_off, int upperm  , const float* gain, float* scr, int item, int lane, int nb_lo = 0, int nb_cnt = 0) {
    constexpr int CPR = KT / 8, NPI = 64 / CPR;
    const int nblk = nb_cnt ? nb_cnt : N / 32, kb = item / nblk, nb = nb_lo + item % nblk, k0 = KT * kb, n0 = 32 * nb;
#pragma unroll
    for (int i = 0; i < KT / 2; ++i) { const int kk = 2 * i + (lane >> 5); float v = W[(size_t)(k0 + kk) * N + n0 + (lane & 31)]; if (gain) v *= gain[k0 + kk]; scr[kk * 33 + (lane & 31)] = v; }
    asm volatile("s_waitcnt lgkmcnt(0)" ::: "memory");
    const int c = lane % CPR;
#pragma unroll
    for (int j = 0; j < 32 / NPI; ++j) { const int n = (lane / CPR) + NPI * j; const float* s = scr + (8 * c) * 33 + n;
        u32x4 o; o.x = pk2(s[0 * 33], s[1 * 33]); o.y = pk2(s[2 * 33], s[3 * 33]); o.z = pk2(s[4 * 33], s[5 * 33]); o.w = pk2(s[6 * 33], s[7 * 33]);
        const int ncol = n0 + n; int drow = row_off + ncol;
        if (upperm == 1) { const int half = ncol >= DFF ? 1 : 0, ch = ncol - half * DFF; drow = 256 * (ch >> 7) + 128 * half + (ch & 127); }
        if (upperm == 2) { const int jg = ncol - ZMAIN, half = jg >= 1024 ? 1 : 0, ch = jg - half * 1024; drow = ZMAIN + 256 * (ch >> 7) + 128 * half + (ch & 127); }
        *(u32x4*)(WT + (size_t)drow * ldk + koff + k0 + 8 * c) = o; }
    asm volatile("s_waitcnt lgkmcnt(0)" ::: "memory");
}

struct P { const float* in[30]; float* out; unsigned char* ws; int ph_lo, ph_hi; };
enum { I_X = 0, I_P, I_LN1, I_WIN, I_MU, I_W0, I_W2, I_A0, I_A2, I_G2, I_KK, I_KA, I_RK, I_LNXW, I_LNXB, I_REL, I_GATEB, I_WBRR, I_WBRA, I_WO, I_LN2, I_WUP, I_CONVW, I_CONVB, I_WDOWN, I_LN3, I_WPLE, I_WPG, I_BPG, I_LNF };

__device__ __forceinline__ void phase0(const P& p, const Ctx& c) {
    float* scr = (float*)(c.lds + c.wave * 16384);
    unsigned char* ws = p.ws;
    constexpr int I1 = 16 * 104, I9 = 16, I10 = 16, I11 = 32;
    constexpr int NITEMS = I1 + I9 + I10 + I11;
    for (int it = c.gw; it < NITEMS; it += c.NGW) {
        int r = it;
        if (r < I1) { p0_transpose_item<64>(p.in[I_WIN], D, 5376, (bf16*)(ws + WS_WIN), D, 0, 0, false, p.in[I_LN1], scr, r, c.lane, 0, 104); continue; } r -= I1;
        if (r < I9) { p0_transpose_item<64>(p.in[I_W2], 64, 512, (bf16*)(ws + WS_BT2), 256, 0, 0, false, nullptr, scr, r, c.lane); continue; } r -= I9;
        if (r < I10) { p0_transpose_item<64>(p.in[I_A2], 64, 512, (bf16*)(ws + WS_BT2), 256, 64, 512, false, nullptr, scr, r, c.lane); continue; } r -= I10;
        p0_transpose_item<64>(p.in[I_G2], 128, 512, (bf16*)(ws + WS_BT2), 256, 128, 1024, false, nullptr, scr, r, c.lane);
    }
    const float* x = p.in[I_X]; bf16* H1 = (bf16*)(ws + WS_XB);
    for (int m = c.gw; m < M; m += 4 * c.NGW) {
        f32x4 v[4][4]; float sq[4];
#pragma unroll
        for (int r = 0; r < 4; ++r) { const f32x4* xr = (const f32x4*)(x + (size_t)(m + r * c.NGW) * D) + c.lane;
#pragma unroll
            for (int j = 0; j < 4; ++j) v[r][j] = xr[64 * j]; }
#pragma unroll
        for (int r = 0; r < 4; ++r) { float s = 0.f;
#pragma unroll
            for (int j = 0; j < 4; ++j) s += (v[r][j].x * v[r][j].x + v[r][j].y * v[r][j].y) + (v[r][j].z * v[r][j].z + v[r][j].w * v[r][j].w);
            sq[r] = s; }
#pragma unroll
        for (int o = 1; o < 64; o <<= 1) {
#pragma unroll
            for (int r = 0; r < 4; ++r) sq[r] += __shfl_xor(sq[r], o); }
#pragma unroll
        for (int r = 0; r < 4; ++r) { const float rs = rsqrtf(sq[r] * (1.f / D) + NORM_EPS); u32x2* o8 = (u32x2*)(H1 + (size_t)(m + r * c.NGW) * D) + c.lane;
#pragma unroll
            for (int j = 0; j < 4; ++j) { u32x2 o; o.x = pk2(v[r][j].x * rs, v[r][j].y * rs); o.y = pk2(v[r][j].z * rs, v[r][j].w * rs); o8[64 * j] = o; } }
    }
}

__device__ __forceinline__ void phase2a(const P& p, const Ctx& c) {
    unsigned char* ws = p.ws;
    const bf16* ZLOW = (const bf16*)(ws + WS_ZLOW); bf16* A2 = (bf16*)((unsigned char*)p.out + O_A2);
    const f32x4 mu = *(const f32x4*)(p.in[I_MU] + 1536 + 4 * c.lane);
    for (int m = c.gw; m < M; m += c.NGW) {
        const u32x2 z = *(const u32x2*)(ZLOW + (size_t)m * 256 + 4 * c.lane);
        u32x2 zp = {0u, 0u}; if ((m & (T - 1)) != 0) zp = *(const u32x2*)(ZLOW + (size_t)(m - 1) * 256 + 4 * c.lane);
        float v[4] = {bflo(z.x), bfhi(z.x), bflo(z.y), bfhi(z.y)}; const float q[4] = {bflo(zp.x), bfhi(zp.x), bflo(zp.y), bfhi(zp.y)};
#pragma unroll
        for (int e = 0; e < 4; ++e) { v[e] = v[e] + (q[e] - v[e]) * mu[e];
            if (c.lane < 16) v[e] = 1.f - 2.f / (1.f + __expf(2.f * v[e])); else if (c.lane >= 32) v[e] = sigmoidf_(v[e]); }
        u32x2 o; o.x = pk2(v[0], v[1]); o.y = pk2(v[2], v[3]); *(u32x2*)(A2 + (size_t)m * 256 + 4 * c.lane) = o;
    }
}

__device__ __forceinline__ unsigned h2pack(float a, float b) { return (unsigned)f2h(a) | ((unsigned)f2h(b) << 16); }
__device__ __forceinline__ void phase2c(const P& p, const Ctx& c) {
    unsigned char* ws = p.ws;
    const bf16* ZRM = (const bf16*)(ws + WS_ZRM); const bf16* A = (const bf16*)((unsigned char*)p.out + O_A);
    unsigned char* PACK = ws + WS_PACK; float* BONUS = (float*)(ws + WS_BONUS);
    const int hq = c.lane >> 4, js = c.lane & 15;
    for (int wi = (int)(blockIdx.x & 7) * 256 + (int)(blockIdx.x >> 3) * 8 + c.wave, once_ = 0; once_ < 1; ++once_) {
        const int hh = wi & 1, chunk = wi >> 1, h = 4 * hh + hq, col = h * 64 + 4 * js; const int mb = chunk * 32;
        const f32x4 mur = *(const f32x4*)(p.in[I_MU] + col), muk = *(const f32x4*)(p.in[I_MU] + 512 + col), muv = *(const f32x4*)(p.in[I_MU] + 1024 + col);
        const f32x4 kkw = *(const f32x4*)(p.in[I_KK] + col), kaw = *(const f32x4*)(p.in[I_KA] + col), rkw = *(const f32x4*)(p.in[I_RK] + col);
        f32x4 pr = {0.f, 0.f, 0.f, 0.f}, pk = pr, pv = pr;
        if ((mb & (T - 1)) != 0) { const bf16* z = ZRM + (size_t)(mb - 1) * 1536 + col; const u32x2 a_ = *(const u32x2*)z, b_ = *(const u32x2*)(z + 512), c_ = *(const u32x2*)(z + 1024);
            pr = (f32x4){bflo(a_.x), bfhi(a_.x), bflo(a_.y), bfhi(a_.y)}; pk = (f32x4){bflo(b_.x), bfhi(b_.x), bflo(b_.y), bfhi(b_.y)}; pv = (f32x4){bflo(c_.x), bfhi(c_.x), bflo(c_.y), bfhi(c_.y)}; }
        const int b = mb / T, t0 = mb % T;
        unsigned char* rec = PACK + ((size_t)((b * NH + h) * T + t0)) * REC + 8 * js;
#pragma unroll 8
        for (int i = 0; i < 32; ++i) {
            const int m = mb + i; const bf16* z = ZRM + (size_t)m * 1536 + col;
            const u32x2 a_ = *(const u32x2*)z, b_ = *(const u32x2*)(z + 512), c_ = *(const u32x2*)(z + 1024), d_ = *(const u32x2*)(A + (size_t)m * 512 + col);
            const f32x4 zr = {bflo(a_.x), bfhi(a_.x), bflo(a_.y), bfhi(a_.y)}, zk = {bflo(b_.x), bfhi(b_.x), bflo(b_.y), bfhi(b_.y)}, zv = {bflo(c_.x), bfhi(c_.x), bflo(c_.y), bfhi(c_.y)}, av = {bflo(d_.x), bfhi(d_.x), bflo(d_.y), bfhi(d_.y)};
            const f32x4 r = zr + (pr - zr) * mur, k = zk + (pk - zk) * muk, v = zv + (pv - zv) * muv; pr = zr; pk = zk; pv = zv;
            const f32x4 kkv = k * kkw; const float ss = allreduce16((kkv.x * kkv.x + kkv.y * kkv.y) + (kkv.z * kkv.z + kkv.w * kkv.w));
            const f32x4 kk = kkv * (1.f / fmaxf(sqrtf(ss), 1e-12f));
            const f32x4 kp = k * (1.f + (av - 1.f) * kaw), bb = kk * av, rb = r * kp * rkw;
            const float bon = allreduce16((rb.x + rb.y) + (rb.z + rb.w));
            unsigned char* q = rec + (size_t)i * REC;
            u32x2 o; o.x = h2pack(-kk.x, -kk.y); o.y = h2pack(-kk.z, -kk.w); *(u32x2*)q = o;
            o.x = h2pack(bb.x, bb.y); o.y = h2pack(bb.z, bb.w); *(u32x2*)(q + 128) = o;
            o.x = h2pack(kp.x, kp.y); o.y = h2pack(kp.z, kp.w); *(u32x2*)(q + 256) = o;
            o.x = h2pack(r.x, r.y); o.y = h2pack(r.z, r.w); *(u32x2*)(q + 384) = o;
            o.x = h2pack(v.x, v.y); o.y = h2pack(v.z, v.w); *(u32x2*)(q + 512) = o;
            if (js == 0) BONUS[(size_t)m * NH + h] = bon;
        }
    }
}

typedef _Float16 h2t __attribute__((ext_vector_type(2)));
__device__ __forceinline__ float mixz_lo(unsigned h, float b) { float d; asm("v_fma_mix_f32 %0, %1, %2, 0 op_sel:[0,0,0] op_sel_hi:[1,0,0]" : "=v"(d) : "v"(h), "v"(b)); return d; }
__device__ __forceinline__ float mix_lo(unsigned h, float b, float c) { float d; asm("v_fma_mix_f32 %0, %1, %2, %3 op_sel:[0,0,0] op_sel_hi:[1,0,0]" : "=v"(d) : "v"(h), "v"(b), "v"(c)); return d; }
__device__ __forceinline__ float mix_hi(unsigned h, float b, float c) { float d; asm("v_fma_mix_f32 %0, %1, %2, %3 op_sel:[1,0,0] op_sel_hi:[1,0,0]" : "=v"(d) : "v"(h), "v"(b), "v"(c)); return d; }
__device__ __forceinline__ float mix2z_ll(unsigned h, unsigned g) { float d; asm("v_fma_mix_f32 %0, %1, %2, 0 op_sel:[0,0,0] op_sel_hi:[1,1,0]" : "=v"(d) : "v"(h), "v"(g)); return d; }
__device__ __forceinline__ float mix2z_lh(unsigned h, unsigned g) { float d; asm("v_fma_mix_f32 %0, %1, %2, 0 op_sel:[0,1,0] op_sel_hi:[1,1,0]" : "=v"(d) : "v"(h), "v"(g)); return d; }
#define CHB 6144
#define SC_G(chsrc, buf) do { const unsigned char* _g = src + (size_t)(chsrc) * CHB + lane * 16; \
        if (dodma) _Pragma("unroll") for (int _i = 0; _i < 6; ++_i) __builtin_amdgcn_global_load_lds((const unsigned*)(_g + _i * 1024), (PG8_LAS unsigned*)(ldsw + (buf) * CHB + _i * 1024), 16, 0, 0); } while (0)
#define SC_RD(X, buf, i) do { const int _o = (buf) * CHB + (i) * REC; nk##X = *(const PG8_LAS u32x2*)(pj + _o); bq##X = *(const PG8_LAS u32x2*)(pj + _o + 128); rq##X = *(const PG8_LAS u32x2*)(pj + _o + 384); \
        nd##X = *(const PG8_LAS u32x2*)(pj + _o + 640); } while (0)
#define SC_RDK(X, buf, i) do { const int _o = (buf) * CHB + (i) * REC; kq##X = *(const PG8_LAS u32x2*)(pj + _o + 256); vh##X = *(const PG8_LAS unsigned short*)(pv + _o); } while (0)
#ifdef PROBE_EXTRA
#define SC_EXTRA "v_fma_mix_f32 %[q], %[ry], %[s2], 0 op_sel:[0,0,0] op_sel_hi:[1,0,0]\n\tv_fma_mix_f32 %[q], %[ry], %[s3], %[q] op_sel:[1,0,0] op_sel_hi:[1,0,0]\n\tv_fma_mix_f32 %[q], %[ry], %[s2], 0 op_sel:[0,0,0] op_sel_hi:[1,0,0]\n\tv_fma_mix_f32 %[q], %[ry], %[s3], %[q] op_sel:[1,0,0] op_sel_hi:[1,0,0]\n\tv_fma_mix_f32 %[q], %[ry], %[s2], 0 op_sel:[0,0,0] op_sel_hi:[1,0,0]\n\tv_fma_mix_f32 %[q], %[ry], %[s3], %[q] op_sel:[1,0,0] op_sel_hi:[1,0,0]\n\tv_fma_mix_f32 %[q], %[ry], %[s2], 0 op_sel:[0,0,0] op_sel_hi:[1,0,0]\n\tv_fma_mix_f32 %[q], %[ry], %[s3], %[q] op_sel:[1,0,0] op_sel_hi:[1,0,0]\n\t"
#else
#define SC_EXTRA
#endif
#define DPPM " row_mask:0xf bank_mask:0xf bound_ctrl:1\n\t"
#define SC_CP(X, par, i, Y, nbuf, ni, kbuf, ki) do { \
        float p_, q_, n0_, n1_, n2_, n3_; \
        asm volatile( \
            "v_fma_mix_f32 %[p], %[nkx], %[s0], 0 op_sel:[0,0,0] op_sel_hi:[1,0,0]\n\t" \
            "v_fma_mix_f32 %[q], %[nky], %[s2], 0 op_sel:[0,0,0] op_sel_hi:[1,0,0]\n\t" \
            "v_add_f32_dpp %[yr], %[yr], %[yr] quad_perm:[1,0,3,2]" DPPM \
            "v_fma_mix_f32 %[p], %[nkx], %[s1], %[p] op_sel:[1,0,0] op_sel_hi:[1,0,0]\n\t" \
            "v_fma_mix_f32 %[q], %[nky], %[s3], %[q] op_sel:[1,0,0] op_sel_hi:[1,0,0]\n\t" \
            "v_add_f32_dpp %[yr], %[yr], %[yr] quad_perm:[2,3,0,1]" DPPM \
            "v_add_f32_e32 %[p], %[p], %[q]\n\t" \
            "s_nop 0\n\t" \
            "v_add_f32_dpp %[yr], %[yr], %[yr] row_half_mirror" DPPM \
            "v_add_f32_dpp %[p], %[p], %[p] quad_perm:[1,0,3,2]" DPPM \
            : [p] "=&v"(p_), [q] "=&v"(q_), [yr] "+v"(yq) \
            : [nkx] "v"(nk##X.x), [nky] "v"(nk##X.y), [s0] "v"(S0), [s1] "v"(S1), [s2] "v"(S2), [s3] "v"(S3)); \
        __builtin_amdgcn_sched_barrier(0); SC_RD(Y, nbuf, ni); SC_RDK(X, kbuf, ki); __builtin_amdgcn_sched_barrier(0); \
        asm volatile( \
            "v_fma_mix_f32 %[n0], %[vh], %[kx], 0 op_sel:[0,0,0] op_sel_hi:[1,1,0]\n\t" \
            "v_add_f32_dpp %[yr], %[yr], %[yr] row_mirror" DPPM \
            "v_add_f32_dpp %[p], %[p], %[p] quad_perm:[2,3,0,1]" DPPM \
            "v_fma_mix_f32 %[n1], %[vh], %[kx], 0 op_sel:[0,1,0] op_sel_hi:[1,1,0]\n\t" \
            "v_fma_mix_f32 %[n2], %[vh], %[ky], 0 op_sel:[0,0,0] op_sel_hi:[1,1,0]\n\t" \
            "v_add_f32_dpp %[p], %[p], %[p] row_half_mirror" DPPM \
            "v_fma_mix_f32 %[n3], %[vh], %[ky], 0 op_sel:[0,1,0] op_sel_hi:[1,1,0]\n\t" \
            "s_nop 0\n\t" \
            "v_add_f32_dpp %[p], %[p], %[p] row_mirror" DPPM \
            "v_fma_mix_f32 %[t0], %[bx], %[p], %[t0] op_sel:[0,0,0] op_sel_hi:[1,0,0]\n\t" \
            "v_fma_mix_f32 %[t1], %[bx], %[p], %[t1] op_sel:[1,0,0] op_sel_hi:[1,0,0]\n\t" \
            "v_fma_mix_f32 %[t2], %[by], %[p], %[t2] op_sel:[0,0,0] op_sel_hi:[1,0,0]\n\t" \
            "v_fma_mix_f32 %[t3], %[by], %[p], %[t3] op_sel:[1,0,0] op_sel_hi:[1,0,0]\n\t" \
            "v_add_f32_e32 %[t0], %[t0], %[s0]\n\t" \
            "v_add_f32_e32 %[t1], %[t1], %[s1]\n\t" \
            "v_add_f32_e32 %[t2], %[t2], %[s2]\n\t" \
            "v_add_f32_e32 %[t3], %[t3], %[s3]\n\t" \
            "v_fma_mix_f32 %[s0], %[ndx], %[s0], %[t0] op_sel:[0,0,0] op_sel_hi:[1,0,0]\n\t" \
            "v_fma_mix_f32 %[s1], %[ndx], %[s1], %[t1] op_sel:[1,0,0] op_sel_hi:[1,0,0]\n\t" \
            "v_fma_mix_f32 %[s2], %[ndy], %[s2], %[t2] op_sel:[0,0,0] op_sel_hi:[1,0,0]\n\t" \
            "v_fma_mix_f32 %[s3], %[ndy], %[s3], %[t3] op_sel:[1,0,0] op_sel_hi:[1,0,0]\n\t" \
            "v_fma_mix_f32 %[p], %[rx], %[s0], 0 op_sel:[0,0,0] op_sel_hi:[1,0,0]\n\t" \
            "v_fma_mix_f32 %[q], %[ry], %[s2], 0 op_sel:[0,0,0] op_sel_hi:[1,0,0]\n\t" \
            "v_fma_mix_f32 %[p], %[rx], %[s1], %[p] op_sel:[1,0,0] op_sel_hi:[1,0,0]\n\t" \
            "v_fma_mix_f32 %[q], %[ry], %[s3], %[q] op_sel:[1,0,0] op_sel_hi:[1,0,0]\n\t" \
            "v_add_f32_e32 %[p], %[p], %[q]\n\t" \
            SC_EXTRA \
            : [p] "+v"(p_), [q] "=&v"(q_), [yr] "+v"(yq), [s0] "+v"(S0), [s1] "+v"(S1), [s2] "+v"(S2), [s3] "+v"(S3), \
              [t0] "+v"(tc0), [t1] "+v"(tc1), [t2] "+v"(tc2), [t3] "+v"(tc3), [n0] "=&v"(n0_), [n1] "=&v"(n1_), [n2] "=&v"(n2_), [n3] "=&v"(n3_) \
            : [vh] "v"(vh##Y), [kx] "v"(kq##Y.x), [ky] "v"(kq##Y.y), [bx] "v"(bq##X.x), [by] "v"(bq##X.y), [rx] "v"(rq##X.x), [ry] "v"(rq##X.y), \
              [ndx] "v"(nd##X.x), [ndy] "v"(nd##X.y)); \
        ykeep = (js == (par) * 8 + (i) - 1) ? yq : ykeep; yq = p_; tc0 = n0_; tc1 = n1_; tc2 = n2_; tc3 = n3_; \
        __builtin_amdgcn_sched_barrier(0); } while (0)
#define SC_EIGHT(buf, par) do { \
        SC_CP(0, par, 0, 1, buf, 1, buf, 2); SC_CP(1, par, 1, 0, buf, 2, buf, 3); SC_CP(0, par, 2, 1, buf, 3, buf, 4); SC_CP(1, par, 3, 0, buf, 4, buf, 5); \
        SC_CP(0, par, 4, 1, buf, 5, buf, 6); SC_CP(1, par, 5, 0, buf, 6, buf, 7); SC_CP(0, par, 6, 1, buf, 7, ((buf) + 1) & 3, 0); SC_CP(1, par, 7, 0, ((buf) + 1) & 3, 0, ((buf) + 1) & 3, 1); } while (0)
#define SC_YOUT(off) do { const float yl_ = allreduce16(yq); ykeep = (js == 15) ? yl_ : ykeep; if (dodma) yp[(size_t)(ch * 8 + (off)) * 512] = (bf16)f2bf(ykeep); yq = 0.f; } while (0)
#define SC_HEAD(k) do { { const int nx = (ch + (k) + 3 < NCH) ? ch + (k) + 3 : NCH - 1; SC_G(nx, ((k) + 3) & 3); } asm volatile("s_waitcnt vmcnt(12)" ::: "memory"); __builtin_amdgcn_sched_barrier(0); } while (0)

__device__ __forceinline__ void scan_unit(const unsigned char* pack, bf16* Y, PG8_LAS unsigned char* ldsw, int unit, int w, int lane, bool dodma) {
    const int xcd_ = unit & 7, idx_ = unit >> 3, bh = xcd_ * 8 + (idx_ >> 2), rg = idx_ & 3, b = bh >> 3, h = bh & 7;
    const int rr = lane >> 4, js = lane & 15, row = rg * 16 + w * 4 + rr;
    const unsigned char* src = pack + (size_t)bh * T * REC;
    bf16* yp = Y + ((size_t)b * T + js) * 512 + h * 64 + row;
    const PG8_LAS unsigned char* pj = ldsw + 8 * js; const PG8_LAS unsigned char* pv = ldsw + 512 + 2 * row; const PG8_LAS unsigned char* pd = ldsw + 640 + 8 * js;
    u32x2 nk0, bq0, kq0, rq0, nk1, bq1, kq1, rq1, nd0, nd1; unsigned vh0, vh1;
    float S0 = 0.f, S1 = 0.f, S2 = 0.f, S3 = 0.f, ykeep = 0.f, yq = 0.f;
    constexpr int NCH = T / 8;
    SC_G(0, 0); SC_G(1, 1); SC_G(2, 2);
    asm volatile("s_waitcnt vmcnt(12)" ::: "memory");
    SC_RD(0, 0, 0); SC_RDK(0, 0, 0); SC_RDK(1, 0, 1);
    float tc0 = mix2z_ll(vh0, kq0.x), tc1 = mix2z_lh(vh0, kq0.x), tc2 = mix2z_ll(vh0, kq0.y), tc3 = mix2z_lh(vh0, kq0.y);
    __builtin_amdgcn_sched_barrier(0);
#pragma unroll 1
    for (int ch = 0; ch < NCH; ch += 4) {
        SC_HEAD(0); SC_EIGHT(0, 0);
        SC_HEAD(1); SC_EIGHT(1, 1);
        SC_YOUT(0);
        SC_HEAD(2); SC_EIGHT(2, 0);
        SC_HEAD(3); SC_EIGHT(3, 1);
        SC_YOUT(16);
    }
    asm volatile("s_waitcnt vmcnt(0)" ::: "memory");
}

#if defined(PROBE_FAKE)
__device__ __forceinline__ void scan_fake(bf16* Y, PG8_LAS unsigned char* ldsw, int lane, int nch) {
    const int js = lane & 15, row = lane >> 4;
    const PG8_LAS unsigned char* pj = ldsw + 8 * js; const PG8_LAS unsigned char* pv = ldsw + 512 + 2 * row; const PG8_LAS unsigned char* pd = ldsw + 640 + 16 * js;
    u32x2 nk0, bq0, kq0, rq0, nk1, bq1, kq1, rq1; unsigned vh0, vh1; f32x4 dd0, dd1;
    float S0 = 0.f, S1 = 0.f, S2 = 0.f, S3 = 0.f, ykeep = 0.f, yq = 0.f;
    SC_RD(0, 0, 0);
    float tc0 = 0.f, tc1 = 0.f, tc2 = 0.f, tc3 = 0.f;
#pragma unroll 1
    for (int ch = 0; ch < nch; ch += 4) { SC_EIGHT(0, 0); SC_EIGHT(1, 1); SC_EIGHT(2, 0); SC_EIGHT(3, 1); }
    if (S0 + S1 + S2 + S3 + ykeep + yq == 1.2345e30f) Y[lane] = (bf16)1;
}
#endif

__device__ __forceinline__ void attn_item(const bf16* QK, const bf16* VT, bf16* OAB, const float* tab, int item, int lane) {
    const int qh = item & 1, cq = (item >> 1) & 63, bh = item >> 7, b = bh >> 3, h = bh & 7;
    const int n = lane & 31, hi = lane >> 5;
    const size_t mq = (size_t)b * T + cq * 64 + qh * 32 + n;
    bf16x8 bq[4];
#pragma unroll
    for (int s = 0; s < 4; ++s) bq[s] = *(const bf16x8*)(QK + mq * 1024 + h * 64 + 16 * s + 8 * hi);
    f32x16 o0, o1;
#pragma unroll
    for (int i = 0; i < 16; ++i) { o0[i] = 0.f; o1[i] = 0.f; }
    float mrun = -1e30f, lrun = 0.f;
    const int pin = (n & ~12) | ((n & 4) << 1) | ((n & 8) >> 1);
    const float* tabh = tab + h * 256; const float c191 = tabh[191];
    for (int j = (cq < 8 ? 8 - cq : 0); j <= 8; ++j) {
        const int kc = cq - 8 + j; const size_t mk0 = (size_t)b * T + (size_t)kc * 64;
        f32x16 x0, x1;
#pragma unroll
        for (int i = 0; i < 16; ++i) { x0[i] = 0.f; x1[i] = 0.f; }
        const bf16* kp0 = QK + (mk0 + pin) * 1024 + 512 + h * 64 + 8 * hi;
#pragma unroll
        for (int s = 0; s < 4; ++s) { const bf16x8 a0 = *(const bf16x8*)(kp0 + 16 * s), a1 = *(const bf16x8*)(kp0 + 32 * 1024 + 16 * s); x0 = MFMA32(a0, bq[s], x0); x1 = MFMA32(a1, bq[s], x1); }
        if (j <= 5) {
#pragma unroll
            for (int i = 0; i < 16; ++i) { x0[i] += c191; x1[i] += c191; }
        } else {
            const float* lp = tabh + (32 * qh + n - 8 * hi + 64 * (8 - j) + 8);
#pragma unroll
            for (int i = 0; i < 16; ++i) { const int ct = 16 * (i >> 3) + 4 * ((i >> 2) & 1) + (i & 3); x0[i] += lp[55 - ct]; x1[i] += lp[23 - ct]; }
        }
        float mx = fmaxf(x0[0], x1[0]);
#pragma unroll
        for (int i = 1; i < 16; ++i) mx = fmaxf(mx, fmaxf(x0[i], x1[i]));
        mx = fmaxf(mx, __shfl_xor(mx, 32));
        const float mnew = fmaxf(mrun, mx), alpha = __builtin_amdgcn_exp2f(mrun - mnew); mrun = mnew;
        float ls = 0.f;
#pragma unroll
        for (int i = 0; i < 16; ++i) { x0[i] = __builtin_amdgcn_exp2f(x0[i] - mnew); x1[i] = __builtin_amdgcn_exp2f(x1[i] - mnew); ls += x0[i] + x1[i]; }
        lrun = lrun * alpha + ls;
#pragma unroll
        for (int i = 0; i < 16; ++i) { o0[i] *= alpha; o1[i] *= alpha; }
        const bf16* vp = VT + ((size_t)(bh * 64 + n)) * T + (size_t)kc * 64 + 8 * hi;
#pragma unroll
        for (int s2 = 0; s2 < 2; ++s2) {
            { const bf16x8 v0 = *(const bf16x8*)(vp + 16 * s2), v1 = *(const bf16x8*)(vp + (size_t)32 * T + 16 * s2); const bf16x8 pb = packstep(x0, s2); o0 = MFMA32(v0, pb, o0); o1 = MFMA32(v1, pb, o1); }
            { const bf16x8 v0 = *(const bf16x8*)(vp + 32 + 16 * s2), v1 = *(const bf16x8*)(vp + (size_t)32 * T + 32 + 16 * s2); const bf16x8 pb = packstep(x1, s2); o0 = MFMA32(v0, pb, o0); o1 = MFMA32(v1, pb, o1); }
        }
    }
    lrun += __shfl_xor(lrun, 32); const float inv = 1.f / lrun;
    bf16* op = OAB + mq * 1024 + 512 + h * 64 + 4 * hi;
#pragma unroll
    for (int g = 0; g < 4; ++g) {
        u32x2 w0, w1; w0.x = cvtpk(o0[4 * g] * inv, o0[4 * g + 1] * inv); w0.y = cvtpk(o0[4 * g + 2] * inv, o0[4 * g + 3] * inv);
        w1.x = cvtpk(o1[4 * g] * inv, o1[4 * g + 1] * inv); w1.y = cvtpk(o1[4 * g + 2] * inv, o1[4 * g + 3] * inv);
        *(u32x2*)(op + 8 * g) = w0; *(u32x2*)(op + 32 + 8 * g) = w1;
    }
}

__device__ __forceinline__ void phase3(const P& p, const Ctx& c) {
    unsigned char* ws = p.ws;
    float* tab = (float*)(c.lds + 4 * 4 * CHB);
    for (int i = c.tid; i < NH * 256; i += NTHR) { const int h = i >> 8, r = i & 255; tab[i] = p.in[I_REL][h * 192 + (r < 191 ? r : 191)] * LOG2E; }
    __syncthreads();
    if (c.wave < 4) {
        __builtin_amdgcn_s_setprio(3);
#ifndef PROBE_SCAN
#define PROBE_SCAN 1
#endif
        for (int rp_ = 0; rp_ < PROBE_SCAN; ++rp_)
        for (int unit = blockIdx.x; unit < 256; unit += c.G)
            scan_unit(ws + WS_PACK, (bf16*)((unsigned char*)p.out + O_Y), (PG8_LAS unsigned char*)c.lds + c.wave * (4 * CHB), unit, c.wave, c.lane, rp_ == 0);
        __builtin_amdgcn_s_setprio(0);
    } else {
        const int aw = blockIdx.x * 4 + (c.wave - 4), NAW = c.G * 4;
#ifndef PROBE_ATT
#define PROBE_ATT 1
#endif
        for (int rp_ = 0; rp_ < PROBE_ATT; ++rp_)
        for (int kb = 0; kb < 8; ++kb) {
            const int xcd_ = blockIdx.x & 7, lw = (blockIdx.x >> 3) * 4 + (c.wave - 4), bh_ = xcd_ * 8 + kb;
            attn_item((const bf16*)(ws + WS_QK), (const bf16*)((unsigned char*)p.out + O_VT), (bf16*)(ws + WS_OAB), tab, bh_ * 128 + lw, c.lane);
        }
        {
          float* scr = (float*)(c.lds + 4 * 4 * CHB + 8192 + (c.wave - 4) * 4224);
          constexpr int J1 = 32 * 64, J2 = 32 * 176, J3 = 88 * 32, J4 = 32 * 32, J5 = 16 * 32, J6 = 16 * 32, J7 = 32 * 32, J8 = 8 * 32;
          constexpr int NJ = J1 + J2 + J3 + J4 + J5 + J6 + J7 + J8;
          for (int it = aw; it < NJ; it += NAW) {
              int r = it;
              if (r < J1) { p0_transpose_item<32>(p.in[I_WIN], D, 5376, (bf16*)(ws + WS_WIN), D, 0, 0, 2, p.in[I_LN1], scr, r, c.lane, 104, 64); continue; } r -= J1;
              if (r < J2) { p0_transpose_item<32>(p.in[I_WUP], D, NUP, (bf16*)(ws + WS_WUP), D, 0, 0, true, p.in[I_LN2], scr, r, c.lane); continue; } r -= J2;
              if (r < J3) { p0_transpose_item<32>(p.in[I_WDOWN], DFF, D, (bf16*)(ws + WS_WDOWN), DFF, 0, 0, false, nullptr, scr, r, c.lane); continue; } r -= J3;
              if (r < J4) { p0_transpose_item<32>(p.in[I_WO], D, D, (bf16*)(ws + WS_WO), D, 0, 0, false, nullptr, scr, r, c.lane); continue; } r -= J4;
              if (r < J5) { p0_transpose_item<32>(p.in[I_WBRR], 512, D, (bf16*)(ws + WS_WBR), D, 0, 0, false, nullptr, scr, r, c.lane); continue; } r -= J5;
              if (r < J6) { p0_transpose_item<32>(p.in[I_WBRA], 512, D, (bf16*)(ws + WS_WBR), D, 512, 0, false, nullptr, scr, r, c.lane); continue; } r -= J6;
              if (r < J7) { p0_transpose_item<32>(p.in[I_WPG], D, D, (bf16*)(ws + WS_WPG), D, 0, 0, false, p.in[I_LN3], scr, r, c.lane); continue; } r -= J7;
              p0_transpose_item<32>(p.in[I_WPLE], PLED, D, (bf16*)(ws + WS_WPLE), PLED, 0, 0, false, nullptr, scr, r, c.lane);
          } }
        {
          const f32x4* pp = (const f32x4*)p.in[I_P]; u32x2* pb = (u32x2*)(ws + WS_PB); const int stride = NAW * 64, total = M * PLED / 4;
          for (int i = aw * 64 + c.lane; i + 3 * stride < total; i += 4 * stride) {
              const f32x4 v0 = pp[i], v1 = pp[i + stride], v2 = pp[i + 2 * stride], v3 = pp[i + 3 * stride];
              u32x2 o; o.x = pk2(v0.x, v0.y); o.y = pk2(v0.z, v0.w); pb[i] = o; o.x = pk2(v1.x, v1.y); o.y = pk2(v1.z, v1.w); pb[i + stride] = o;
              o.x = pk2(v2.x, v2.y); o.y = pk2(v2.z, v2.w); pb[i + 2 * stride] = o; o.x = pk2(v3.x, v3.y); o.y = pk2(v3.z, v3.w); pb[i + 3 * stride] = o; } }
#if defined(PROBE_FAKE)
        scan_fake((bf16*)((unsigned char*)p.out + O_Y), (PG8_LAS unsigned char*)c.lds + (c.wave - 4) * 28672, c.lane, PROBE_FAKE);
#endif
    }
}

__device__ __forceinline__ void phase35a(const P& p, const Ctx& c) {
    unsigned char* ws = p.ws;
    const bf16* Y = (const bf16*)((unsigned char*)p.out + O_Y); const bf16* Gm = (const bf16*)((unsigned char*)p.out + O_G);
    const unsigned char* PACK = ws + WS_PACK; const float* BONUS = (const float*)(ws + WS_BONUS); bf16* OAB = (bf16*)(ws + WS_OAB);
    const int hq = c.lane >> 4, js = c.lane & 15;
    for (int wi = (int)(blockIdx.x & 7) * 256 + (int)(blockIdx.x >> 3) * 8 + c.wave, once_ = 0; once_ < 1; ++once_) {
        const int hh = wi & 1, chunk = wi >> 1, h = 4 * hh + hq, col = h * 64 + 4 * js, mb = chunk * 32, b = mb / T, t0 = mb % T;
        const f32x4 lw = *(const f32x4*)(p.in[I_LNXW] + col), lb = *(const f32x4*)(p.in[I_LNXB] + col);
        const unsigned char* rec = PACK + ((size_t)((b * NH + h) * T + t0)) * REC + 512 + 8 * js;
#pragma unroll 8
        for (int i = 0; i < 32; ++i) {
            const size_t m = (size_t)(mb + i);
            const u32x2 y_ = *(const u32x2*)(Y + m * 512 + col), g_ = *(const u32x2*)(Gm + m * 512 + col), v_ = *(const u32x2*)(rec + (size_t)i * REC);
            const f32x4 y = {bflo(y_.x), bfhi(y_.x), bflo(y_.y), bfhi(y_.y)}, g = {bflo(g_.x), bfhi(g_.x), bflo(g_.y), bfhi(g_.y)};
            const h4 vh = __builtin_bit_cast(h4, v_); const f32x4 v = {(float)vh.x, (float)vh.y, (float)vh.z, (float)vh.w};
            const float mean = allreduce16((y.x + y.y) + (y.z + y.w)) * (1.f / 64); const f32x4 dy = y - mean;
            const float var = allreduce16((dy.x * dy.x + dy.y * dy.y) + (dy.z * dy.z + dy.w * dy.w)) * (1.f / 64);
            const f32x4 o = (dy * rsqrtf(var + GN_EPS) * lw + lb + v * BONUS[m * NH + h]) * g;
            u32x2 w; w.x = pk2(o.x, o.y); w.y = pk2(o.z, o.w); *(u32x2*)(OAB + m * 1024 + col) = w;
        }
    }
}

__device__ __forceinline__ void phase5b(const P& p, const Ctx& c, int wr) {
    bf16* U = (bf16*)(p.ws + WS_U);
    const float* cw = p.in[I_CONVW]; const float* cb = p.in[I_CONVB];
    constexpr int RUN = 16, NCH16 = DFF / 8;
    const int total = (M / RUN) * NCH16;
    for (int it = blockIdx.x * NTHR + c.tid; it < total; it += c.G * NTHR) {
        const int run = it / NCH16, ck = it % NCH16, ch0 = ck * 8, blk = ch0 >> 7, j0 = ch0 & 127;
        const int m0 = run * RUN, t0 = m0 & (T - 1);
        float w0[8], w1[8], w2[8], bb[8];
#pragma unroll
        for (int e = 0; e < 8; ++e) { w0[e] = cw[ch0 + e]; w1[e] = cw[DFF + ch0 + e]; w2[e] = cw[2 * DFF + ch0 + e]; bb[e] = cb[ch0 + e]; }
        bf16* ua = U + (size_t)m0 * NUP + 256 * blk + j0;
        float a1[8], a2[8];
        if (t0 == 0) {
#pragma unroll
            for (int e = 0; e < 8; ++e) { a1[e] = 0.f; a2[e] = 0.f; }
        } else {
            f32x4 x0, x1; unpack8(*(const u32x4*)(ua - NUP), x0, x1); f32x4 y0, y1; unpack8(*(const u32x4*)(ua - 2 * NUP), y0, y1);
#pragma unroll
            for (int e = 0; e < 4; ++e) { a1[e] = x0[e]; a1[4 + e] = x1[e]; a2[e] = y0[e]; a2[4 + e] = y1[e]; }
        }
#pragma unroll 4
        for (int i = 0; i < RUN; ++i) {
            bf16* ur = ua + (size_t)i * NUP;
            f32x4 x0, x1, g0, g1; unpack8(*(const u32x4*)ur, x0, x1); unpack8(*(const u32x4*)(ur + 128), g0, g1);
            float a0[8], r[8];
#pragma unroll
            for (int e = 0; e < 4; ++e) { a0[e] = x0[e]; a0[4 + e] = x1[e]; }
#pragma unroll
            for (int e = 0; e < 8; e += 2) {
                f32x2 cv; cv.x = bb[e] + w0[e] * a2[e] + w1[e] * a1[e] + w2[e] * a0[e]; cv.y = bb[e + 1] + w0[e + 1] * a2[e + 1] + w1[e + 1] * a1[e + 1] + w2[e + 1] * a0[e + 1];
                const f32x2 ge = pg8::gelu_pk(cv); r[e] = ge.x; r[e + 1] = ge.y;
            }
#pragma unroll
            for (int e = 0; e < 8; ++e) { a2[e] = a1[e]; a1[e] = a0[e]; }
            f32x4 r0 = {r[0] * g0[0], r[1] * g0[1], r[2] * g0[2], r[3] * g0[3]}, r1 = {r[4] * g1[0], r[5] * g1[1], r[6] * g1[2], r[7] * g1[3]};
            if (wr) *(u32x4*)(ur + 128) = pack8(r0, r1);
        }
    }
}

__device__ __forceinline__ void phase5b_fix(const P& p, const Ctx& c) {
    bf16* ACT = (bf16*)(p.ws + WS_U); const bf16* ARAW = ACT + (size_t)M * DFF;
    const float* cw = p.in[I_CONVW]; const float* cb = p.in[I_CONVB];
    constexpr int NCH16 = DFF / 8;
    const int total = (M / 32) * NCH16;
    for (int it = blockIdx.x * NTHR + c.tid; it < total; it += c.G * NTHR) {
        const int rid = it / NCH16, ck = it % NCH16, ch0 = ck * 8;
        const int m = (rid >> 1) * 64 + (rid & 1), t = m & (T - 1), slot = 4 * (m >> 6) + (m & 63);
        bf16* ur = ACT + (size_t)m * DFF + ch0; const bf16* ar = ARAW + (size_t)slot * DFF + ch0;
        f32x4 x0, x1, g0, g1, y0 = {0.f, 0.f, 0.f, 0.f}, y1 = y0, z0 = y0, z1 = y0;
        unpack8(*(const u32x4*)ar, x0, x1); unpack8(*(const u32x4*)ur, g0, g1);
        if (t >= 1) unpack8(*(const u32x4*)(ar - DFF), y0, y1);
        if (t >= 2) unpack8(*(const u32x4*)(ar - 2 * DFF), z0, z1);
        const f32x4 w00 = *(const f32x4*)(cw + ch0), w01 = *(const f32x4*)(cw + ch0 + 4), w10 = *(const f32x4*)(cw + DFF + ch0), w11 = *(const f32x4*)(cw + DFF + ch0 + 4);
        const f32x4 w20 = *(const f32x4*)(cw + 2 * DFF + ch0), w21 = *(const f32x4*)(cw + 2 * DFF + ch0 + 4), b0 = *(const f32x4*)(cb + ch0), b1 = *(const f32x4*)(cb + ch0 + 4);
        const f32x4 c0 = b0 + w00 * z0 + w10 * y0 + w20 * x0, c1 = b1 + w01 * z1 + w11 * y1 + w21 * x1;
        const f32x2 e0 = pg8::gelu_pk((f32x2){c0[0], c0[1]}), e1 = pg8::gelu_pk((f32x2){c0[2], c0[3]}), e2 = pg8::gelu_pk((f32x2){c1[0], c1[1]}), e3 = pg8::gelu_pk((f32x2){c1[2], c1[3]});
        const f32x4 r0 = {e0.x * g0[0], e0.y * g0[1], e1.x * g0[2], e1.y * g0[3]}, r1 = {e2.x * g1[0], e2.y * g1[1], e3.x * g1[2], e3.y * g1[3]};
        *(u32x4*)ur = pack8(r0, r1);
    }
}

__device__ __forceinline__ void phase8(const P& p, const Ctx& c, int wr) {
    const float* SSF = (const float*)(p.ws + WS_SSF); const f32x4* gf = (const f32x4*)p.in[I_LNF] + c.lane;
    const bf16* X3 = (const bf16*)(p.ws + WS_X3);
    f32x4 g[4];
#pragma unroll
    for (int j = 0; j < 4; ++j) g[j] = gf[64 * j];
    for (int m = c.gw; m < M; m += 2 * c.NGW) {
        const int m2 = m + c.NGW;
        const float rs = rsqrtf(SSF[m] * (1.f / D) + NORM_EPS), rs2 = rsqrtf(SSF[m2] * (1.f / D) + NORM_EPS);
        const u32x2* xr = (const u32x2*)(X3 + (size_t)m * D) + c.lane; const u32x2* xq = (const u32x2*)(X3 + (size_t)m2 * D) + c.lane;
        f32x4* orow = (f32x4*)(p.out + (size_t)m * D) + c.lane; f32x4* oq = (f32x4*)(p.out + (size_t)m2 * D) + c.lane;
        u32x2 v[4], w[4];
#pragma unroll
        for (int j = 0; j < 4; ++j) { v[j] = xr[64 * j]; w[j] = xq[64 * j]; }
#pragma unroll
        for (int j = 0; j < 4; ++j) {
            const f32x4 a = {bflo(v[j].x), bfhi(v[j].x), bflo(v[j].y), bfhi(v[j].y)}, b = {bflo(w[j].x), bfhi(w[j].x), bflo(w[j].y), bfhi(w[j].y)};
            if (wr) { orow[64 * j] = a * rs * g[j]; oq[64 * j] = b * rs2 * g[j]; }
        }
    }
}

constexpr int NPHASE = 16;
__global__ void __launch_bounds__(NTHR, 2) mk_fwd(P p) {
    extern __shared__ __attribute__((aligned(16))) unsigned char lds[];
    cg::grid_group grid = cg::this_grid();
    const int wave_s = __builtin_amdgcn_readfirstlane((int)(threadIdx.x >> 6));
    volatile PG8_LAS unsigned* misc = (volatile PG8_LAS unsigned*)((PG8_LAS unsigned char*)lds + LDS_BYTES - 256);
    if (threadIdx.x < 32) misc[threadIdx.x] = 0u;
    __syncthreads();
    if (p.ph_lo < 0) grid.sync();
    const XcdBarrier xbar = xcd_barrier_post((unsigned*)(p.ws + WS_BAR), misc + 8);
#define MKCTX Ctx c; c.lds = lds; c.lane = vlane_id(); c.wave = wave_s; c.tid = wave_s * 64 + c.lane; c.G = gridDim.x; c.gw = blockIdx.x * NWAVES + c.wave; c.NGW = c.G * NWAVES;
    unsigned char* ws = p.ws; unsigned char* ob = (unsigned char*)p.out;
    PG8_LAS unsigned char* ring = (PG8_LAS unsigned char*)lds;
    const int lo = p.ph_lo, hi = p.ph_hi;
#ifndef FUSE_ALIGN
#define FUSE_ALIGN true
#endif
#ifndef PROBE_REP
#define PROBE_REP 0
#endif
#ifndef PROBE_BAR2
#define PROBE_BAR2 0
#endif
#define REPS(k) (1 + ((PROBE_REP >> (k)) & 1))
#ifndef PH_MASK
#define PH_MASK 0xFFFF
#endif
#define IN(k) (((PH_MASK >> (k)) & 1) && lo <= (k) && (k) < hi)
#define SEAM(k) do { if (IN(k) && IN((k) + 1)) { { xcd_barrier(xbar, wave_s * 64 + vlane_id()); if (PROBE_BAR2) xcd_barrier(xbar, wave_s * 64 + vlane_id()); } } } while (0)
    typedef pg8::StaticOrder SO;
    if (IN(0)) for (int rep_ = 0; rep_ < REPS(0); ++rep_) { MKCTX phase0(p, c); } SEAM(0);
    if (IN(1)) for (int rep_ = 0; rep_ < REPS(1); ++rep_) {
        { pg8::Gemm g{(const bf16*)(ws + WS_XB), (const bf16*)(ws + WS_WIN), M, 2816, D, D, 256}; SO S; S.init(M, 2816, gridDim.x, blockIdx.x);
          EpiZ E{(bf16*)(ws + WS_ZRM), (bf16*)(ws + WS_ZLOW), (bf16*)(ws + WS_QK), (bf16*)(ws + WS_V)};
          pg8::gemm_phase<EpiZ, SO, true>(ring, g, S, E, wave_s, vlane_id()); }
        {
          pg8::Gemm g{(const bf16*)(ws + WS_WIN) + (size_t)2816 * D, (const bf16*)(ws + WS_XB), 512, M, D, D, 256}; SO S; S.init(512, M, gridDim.x, blockIdx.x);
          EpiVT E{(bf16*)(ob + O_VT)};
          pg8::gemm_phase<EpiVT, SO, true>(ring, g, S, E, wave_s, vlane_id()); } } SEAM(1);
    if (IN(2)) for (int rep_ = 0; rep_ < REPS(2); ++rep_) { MKCTX phase2a(p, c); } SEAM(2);
    if (IN(3)) for (int rep_ = 0; rep_ < REPS(3); ++rep_) { pg8::Gemm g{(const bf16*)(ob + O_A2), (const bf16*)(ws + WS_BT2), M, 1536, 256, 256, 256}; SO S; S.init(M, 1536, gridDim.x, blockIdx.x);
        EpiLR E{ws + WS_PACK, (bf16*)(ob + O_A), (bf16*)(ob + O_G), p.in[I_W0], p.in[I_A0]};
        pg8::gemm_phase<EpiLR, SO, true>(ring, g, S, E, wave_s, vlane_id()); } SEAM(3);
    if (IN(4)) for (int rep_ = 0; rep_ < REPS(4); ++rep_) { MKCTX phase2c(p, c); } SEAM(4);
    if (IN(5)) for (int rep_ = 0; rep_ < REPS(5); ++rep_) { MKCTX phase3(p, c); } SEAM(5);
    if (IN(6)) for (int rep_ = 0; rep_ < REPS(6); ++rep_) { MKCTX phase35a(p, c); } SEAM(6);
    if (IN(7)) for (int rep_ = 0; rep_ < REPS(7); ++rep_) { pg8::Gemm g{(const bf16*)(ws + WS_XB), (const bf16*)(ws + WS_WIN) + (size_t)ZMAIN * D, M, NGATE, D, D, 256}; SO S; S.init(M, NGATE, gridDim.x, blockIdx.x);
        EpiGate E{(bf16*)(ws + WS_GATES), p.in[I_GATEB]};
        pg8::gemm_phase<EpiGate, SO, true>(ring, g, S, E, wave_s, vlane_id()); } SEAM(7);
    if (IN(8)) for (int rep_ = 0; rep_ < REPS(8); ++rep_) { pg8::Gemm g{(const bf16*)(ws + WS_OAB), (const bf16*)(ws + WS_WBR), M, D, D, D, 256}; SO S; S.init(M, D, gridDim.x, blockIdx.x);
        EpiMerge E{(const bf16*)(ws + WS_GATES), (bf16*)(ws + WS_MERGED)};
        pg8::gemm_phase<EpiMerge, SO, true>(ring, g, S, E, wave_s, vlane_id()); } SEAM(8);
    if (IN(9)) for (int rep_ = 0; rep_ < REPS(9); ++rep_) { pg8::Gemm g{(const bf16*)(ws + WS_MERGED), (const bf16*)(ws + WS_WO), M, D, D, D, 256}; SO S; S.init(M, D, gridDim.x, blockIdx.x);
        EpiRes E{p.in[I_X], (bf16*)(ws + WS_XB), (float*)(ws + WS_SS2), rep_ == REPS(9) - 1};
        pg8::gemm_phase<EpiRes, SO, true>(ring, g, S, E, wave_s, vlane_id()); } SEAM(9);
    if (IN(10)) for (int rep_ = 0; rep_ < REPS(10); ++rep_) { pg8::Gemm g{(const bf16*)(ws + WS_XB), (const bf16*)(ws + WS_WUP), M, NUP, D, D, 256}; SO S; S.init(M, NUP, gridDim.x, blockIdx.x);
        EpiUpAct E{(bf16*)(ws + WS_U), (const float*)(ws + WS_SS2), p.in[I_CONVW], p.in[I_CONVB]};
        pg8::gemm_phase<EpiUpAct, SO, FUSE_ALIGN>(ring, g, S, E, wave_s, vlane_id()); } SEAM(10);
    if (IN(11)) { { MKCTX phase5b_fix(p, c); }
        pg8::Gemm g{(const bf16*)(ws + WS_PB), (const bf16*)(ws + WS_WPLE), M, D, PLED, PLED, 256}; SO S; S.init(M, D, gridDim.x, blockIdx.x);
        EpiPlain E{(bf16*)ob, D};
        pg8::gemm_phase<EpiPlain, SO, true>(ring, g, S, E, wave_s, vlane_id()); } SEAM(11);
    if (IN(12)) for (int rep_ = 0; rep_ < REPS(12); ++rep_) { pg8::Gemm g{(const bf16*)(ws + WS_U), (const bf16*)(ws + WS_WDOWN), M, D, DFF, DFF, 256}; SO S; S.init(M, D, gridDim.x, blockIdx.x);
        EpiResB E{(bf16*)(ws + WS_XB), (float*)(ws + WS_SS3), rep_ == REPS(12) - 1};
        pg8::gemm_phase<EpiResB, SO, true>(ring, g, S, E, wave_s, vlane_id()); } SEAM(12);
    if (IN(14)) for (int rep_ = 0; rep_ < REPS(14); ++rep_) { pg8::Gemm g{(const bf16*)(ws + WS_XB), (const bf16*)(ws + WS_WPG), M, D, D, D, 256}; SO S; S.init(M, D, gridDim.x, blockIdx.x);
        EpiFinal E{(bf16*)(ws + WS_X3), (const bf16*)(ws + WS_XB), (const bf16*)ob, (const float*)(ws + WS_SS3), p.in[I_BPG], (float*)(ws + WS_SSF), rep_ == REPS(14) - 1};
        pg8::gemm_phase<EpiFinal, SO, true>(ring, g, S, E, wave_s, vlane_id()); } SEAM(14);
    if (IN(15)) for (int rep_ = 0; rep_ < REPS(15); ++rep_) { MKCTX phase8(p, c, rep_ == REPS(15) - 1); }
#undef IN
#undef SEAM
}

#ifndef MK_PER_PHASE
#define MK_PER_PHASE 0
#endif
extern "C" void kernel_launch(void* const* d_in, const int* in_sizes, int n_in, void* d_out, int out_size, void* d_ws, size_t ws_size, hipStream_t stream) {
    static int grid = 0;
    if (grid == 0) {
        if (n_in != 30 || out_size != M * D || ws_size < WS_END) { fprintf(stderr, "kernel_launch: unexpected shapes (n_in %d out %d ws %zu)\n", n_in, out_size, ws_size); grid = -1; return; }
        int dev = 0, cus = 0, per_cu = 0;
        hipGetDevice(&dev); hipDeviceGetAttribute(&cus, hipDeviceAttributeMultiprocessorCount, dev);
        hipFuncSetAttribute((const void*)mk_fwd, hipFuncAttributeMaxDynamicSharedMemorySize, LDS_BYTES);
        hipOccupancyMaxActiveBlocksPerMultiprocessor(&per_cu, (const void*)mk_fwd, NTHR, LDS_BYTES);
        if (per_cu < 1) { fprintf(stderr, "kernel_launch: occupancy query says %d blocks/CU\n", per_cu); per_cu = 1; }
        grid = cus * (per_cu > 1 ? 1 : per_cu);
        if (grid > 256) grid = 256;
        if (grid != 256) { fprintf(stderr, "kernel_launch: this kernel is laid out for 256 co-resident workgroups; got %d\n", grid); grid = -1; return; }
        if ((M % (4 * grid * NWAVES)) != 0) { fprintf(stderr, "kernel_launch: grid %d does not divide the row count\n", grid); grid = -1; return; }
    }
    if (grid < 0) return;
    hipMemsetAsync(d_ws, 0, CTL_BYTES, stream);
    P p{};
    for (int i = 0; i < 30; ++i) p.in[i] = (const float*)d_in[i];
    p.out = (float*)d_out; p.ws = (unsigned char*)d_ws;
#if MK_PER_PHASE
    for (int k = 0; k < NPHASE; ++k) { p.ph_lo = k; p.ph_hi = k + 1; hipLaunchKernelGGL(mk_fwd, dim3(grid), dim3(NTHR), LDS_BYTES, stream, p); }
#else
    p.ph_lo = 0; p.ph_hi = NPHASE;
    void* args[] = {&p};
    hipError_t e = hipLaunchCooperativeKernel((const void*)mk_fwd, dim3(grid), dim3(NTHR), args, LDS_BYTES, stream);
    if (e != hipSuccess) fprintf(stderr, "cooperative launch failed: %s (grid %d)\n", hipGetErrorString(e), grid);
#endif
}
```

```cpp
#include <hip/hip_runtime.h>
#include <hip/hip_cooperative_groups.h>
#include <cstdio>
#include <cstdint>
namespace cg = cooperative_groups;

namespace pg8 {
#define PG8_LAS __attribute__((address_space(3)))
typedef unsigned short bf16_t;
typedef short bf16x8 __attribute__((ext_vector_type(8)));
typedef float f32x4 __attribute__((ext_vector_type(4)));
typedef unsigned u32x4 __attribute__((ext_vector_type(4)));
constexpr int BM = 256, BK = 64, HALF = 128, HTB = HALF * BK * 2  , STAGE_BYTES = 8 * HTB, NXCD = 8, WGM = 8;

__host__ __device__ __forceinline__ int lds_byte(int r, int c) { const int st = (r >> 4) * 2 + (c >> 5), rr = r & 15, cc = c & 31, ob = rr * 64 + cc * 2; return st * 1024 + (ob ^ (((ob >> 9) & 1) << 5)); }
__host__ __device__ __forceinline__ void stage_rc(int b, int& R, int& C) { const int st = b / 1024, sb = b % 1024, swz = sb ^ (((sb >> 9) & 1) << 5); R = (st >> 1) * 16 + swz / 64; C = (st & 1) * 32 + (swz % 64) / 2; }
__host__ __device__ __forceinline__ int perm32(int rho) { const int n = rho >> 4, i = rho & 15; return 8 * (i >> 2) + 4 * n + (i & 3); }

struct Unit { int pm, pn; };
struct Gemm { const bf16_t* A; const bf16_t* Bt; int M, N, K; int lda; int kpairA; };

struct StaticOrder {
    int nM, nN, nwg, G, c;
    __host__ __device__ void init(int M, int N, int G_, int c_) { nM = M / BM; nN = N / BM; nwg = nM * nN; G = G_; c = c_; }
    __host__ __device__ bool next(int i, Unit& u) const {
        const long L = (long)i * G + c; if (L >= nwg) return false;
        int wgid = (int)L; { const int q = nwg / NXCD, r = nwg % NXCD, xcd = wgid % NXCD, off = wgid / NXCD; wgid = (xcd < r ? xcd * (q + 1) : r * (q + 1) + (xcd - r) * q) + off; }
        const int nig = WGM * nN, gid = wgid / nig, fm = gid * WGM, gsz = (nM - fm) < WGM ? (nM - fm) : WGM;
        u.pm = fm + ((wgid % nig) % gsz); u.pn = (wgid % nig) / gsz; return true;
    }
};

__device__ __forceinline__ unsigned cvt_pk_bf16(float lo, float hi) { unsigned r; asm volatile("v_cvt_pk_bf16_f32 %0, %1, %2" : "=v"(r) : "v"(lo), "v"(hi)); return r; }
typedef float f32x2 __attribute__((ext_vector_type(2)));
__device__ __forceinline__ f32x2 gelu_pk(f32x2 v) {
    const f32x2 av = __builtin_elementwise_abs(v), d = av * 0.2316418882f + 1.0f;
    f32x2 t; t.x = __builtin_amdgcn_rcpf(d.x); t.y = __builtin_amdgcn_rcpf(d.y);
    f32x2 q = t * 0.5307027145f + (-0.7265760135f); q = q * t + 0.7107068705f; q = q * t + (-0.142248368f); q = q * t + 0.127414796f; q = q * t;
    const f32x2 s = (v * v) * (-0.72134752044f);
    f32x2 e; e.x = __builtin_amdgcn_exp2f(s.x); e.y = __builtin_amdgcn_exp2f(s.y);
    const f32x2 m = v * (q * e), r = v - m;
    f32x2 o; o.x = v.x < 0.f ? m.x : r.x; o.y = v.y < 0.f ? m.y : r.y; return o;
}

template <class Epi, class Sched, bool ALIGN_EPI>
__device__ __forceinline__ void gemm_phase(PG8_LAS unsigned char* lds, const Gemm g, const Sched& S, const Epi& E, int wid_in, int lane_in) {
    const int wid = __builtin_amdgcn_readfirstlane(wid_in), lane = lane_in, tid = wid * 64 + lane, wr = wid >> 2, wc = wid & 3, fr = lane & 15, fq = lane >> 4;
    const int K = g.K, nt = K / BK;
    unsigned voffA[2], voffB[2];
#pragma unroll
    for (int i = 0; i < 2; ++i) { int R, C; stage_rc(tid * 16 + i * 8192, R, C); const int Rb = (R & ~31) + perm32(R & 31);
        voffA[i] = (unsigned)(R * g.lda + C) * 2u; voffB[i] = (unsigned)(Rb * K + C) * 2u; }
    const size_t kstep = (size_t)(BK * 2);
    const size_t kpairA = (size_t)g.kpairA;
    const size_t hstepA = (size_t)HALF * g.lda * 2, hstepB = (size_t)HALF * K * 2;
    const size_t tstepA = 2 * hstepA, tstepB = 2 * hstepB;
    const unsigned ldsw = (unsigned)wid * 1024u;
    const int aoff = lds_byte(wr * 64 + fr, fq * 8), boff = lds_byte(wc * 32 + fr, fq * 8);
#define PG8_SA(b, h) (((b) * 2 + (h)) * HTB)
#define PG8_SB(b, h) ((4 + (b) * 2 + (h)) * HTB)
#define PG8_STAGE(bufoff, gbase, voff) do { _Pragma("unroll") for (int _i = 0; _i < 2; ++_i) \
        __builtin_amdgcn_global_load_lds((const unsigned*)((const char*)(gbase) + (voff)[_i]), (PG8_LAS unsigned*)(lds + (bufoff) + ldsw + _i * 8192), 16, 0, 0); } while (0)
#define PG8_LDA(dst, b, h) do { _Pragma("unroll") for (int m = 0; m < 4; ++m) _Pragma("unroll") for (int k = 0; k < 2; ++k) dst[m][k] = *(const PG8_LAS bf16x8*)(lds + PG8_SA(b, h) + aoff + m * 2048 + k * 1024); } while (0)
#define PG8_LDB(dst, b, h) do { _Pragma("unroll") for (int n = 0; n < 2; ++n) _Pragma("unroll") for (int k = 0; k < 2; ++k) dst[n][k] = *(const PG8_LAS bf16x8*)(lds + PG8_SB(b, h) + boff + n * 2048 + k * 1024); } while (0)
#define PG8_MMA(ai, bj, At, Bt) do { __builtin_amdgcn_s_setprio(1); _Pragma("unroll") for (int m = 0; m < 4; ++m) _Pragma("unroll") for (int n = 0; n < 2; ++n) _Pragma("unroll") for (int k = 0; k < 2; ++k) \
        acc[ai][bj][m][n] = __builtin_amdgcn_mfma_f32_16x16x32_bf16(Bt[n][k], At[m][k], acc[ai][bj][m][n], 0, 0, 0); __builtin_amdgcn_s_setprio(0); } while (0)
#define PG8_WAIT_V(n) asm volatile("s_waitcnt vmcnt(" #n ")" ::: "memory")
#define PG8_WAIT_L(n) asm volatile("s_waitcnt lgkmcnt(" #n ")" ::: "memory")
#define PG8_BAR __builtin_amdgcn_s_barrier()
#define PG8_SCHED __builtin_amdgcn_sched_barrier(0)
    Unit cur, nxt; int ui = 0;
    if (!S.next(0, cur)) return;
    f32x4 acc[2][2][4][2];
#pragma unroll
    for (int a = 0; a < 2; ++a)
#pragma unroll
        for (int b = 0; b < 2; ++b)
#pragma unroll
            for (int m = 0; m < 4; ++m)
#pragma unroll
                for (int n = 0; n < 2; ++n) acc[a][b][m][n] = (f32x4){0.f, 0.f, 0.f, 0.f};
    bf16x8 At[4][2], B0[2][2], B1[2][2];
    const char* cA = (const char*)g.A + (size_t)cur.pm * tstepA; const char* cB = (const char*)g.Bt + (size_t)cur.pn * tstepB;
    PG8_STAGE(PG8_SB(0, 0), cB, voffB); PG8_STAGE(PG8_SB(0, 1), cB + hstepB, voffB); PG8_STAGE(PG8_SA(0, 0), cA, voffA); PG8_STAGE(PG8_SA(0, 1), cA + hstepA, voffA);
    if (wr == 1) PG8_BAR;
    PG8_WAIT_V(2); PG8_BAR;
    PG8_STAGE(PG8_SB(1, 0), cB + kstep, voffB); PG8_STAGE(PG8_SA(1, 0), cA + kstep, voffA); PG8_STAGE(PG8_SB(1, 1), cB + hstepB + kstep, voffB);
    PG8_WAIT_V(6); PG8_BAR;
    for (;;) {
        const bool has_next = S.next(ui + 1, nxt);
        const char* nA = has_next ? (const char*)g.A + (size_t)nxt.pm * tstepA : cA; const char* nB = has_next ? (const char*)g.Bt + (size_t)nxt.pn * tstepB : cB;
#pragma unroll 1
        for (int t = 0; t < nt; t += 2) {
            if constexpr (Epi::MID) { if (t == (nt >> 1)) E.mid(acc, cur, wr, wc, fr, fq); }
            const bool last = (t == nt - 2);
            const char* a1 = cA + (size_t)(t >> 1) * kpairA + kstep;
            const char* a2 = last ? nA : cA + (size_t)((t >> 1) + 1) * kpairA; const char* b2 = last ? nB : cB + (size_t)(t + 2) * kstep;
            const char* a3 = a2 + kstep; const char* b3 = b2 + kstep;
            PG8_LDB(B0, 0, 0); PG8_LDB(B1, 0, 1); PG8_SCHED; PG8_LDA(At, 0, 0); PG8_STAGE(PG8_SA(1, 1), a1 + hstepA, voffA);
            PG8_WAIT_V(8); PG8_WAIT_L(0); PG8_BAR; PG8_MMA(0, 0, At, B0); PG8_MMA(0, 1, At, B1); PG8_BAR; PG8_SCHED;
            PG8_LDA(At, 0, 1); PG8_STAGE(PG8_SB(0, 0), b2, voffB); PG8_STAGE(PG8_SB(0, 1), b2 + hstepB, voffB); PG8_STAGE(PG8_SA(0, 0), a2, voffA);
            PG8_WAIT_V(8); PG8_WAIT_L(0); PG8_BAR; PG8_MMA(1, 0, At, B0); PG8_MMA(1, 1, At, B1); PG8_BAR; PG8_SCHED;
            PG8_LDB(B0, 1, 0); PG8_LDB(B1, 1, 1); PG8_SCHED; PG8_LDA(At, 1, 0); PG8_STAGE(PG8_SA(0, 1), a2 + hstepA, voffA);
            PG8_WAIT_V(8); PG8_WAIT_L(0); PG8_BAR; PG8_MMA(0, 0, At, B0); PG8_MMA(0, 1, At, B1); PG8_BAR; PG8_SCHED;
            PG8_LDA(At, 1, 1); PG8_STAGE(PG8_SB(1, 0), b3, voffB); PG8_STAGE(PG8_SB(1, 1), b3 + hstepB, voffB); PG8_STAGE(PG8_SA(1, 0), a3, voffA);
            PG8_WAIT_V(8); PG8_WAIT_L(0); PG8_BAR; PG8_MMA(1, 0, At, B0); PG8_MMA(1, 1, At, B1); PG8_BAR; PG8_SCHED;
        }
        if constexpr (ALIGN_EPI) { if (wr == 0) PG8_BAR; }
        E(acc, cur, wr, wc, fr, fq);
        if (!has_next) break;
#pragma unroll
        for (int a = 0; a < 2; ++a)
#pragma unroll
            for (int b = 0; b < 2; ++b)
#pragma unroll
                for (int m = 0; m < 4; ++m)
#pragma unroll
                    for (int n = 0; n < 2; ++n) acc[a][b][m][n] = (f32x4){0.f, 0.f, 0.f, 0.f};
        cur = nxt; cA = nA; cB = nB; ++ui;
        if constexpr (ALIGN_EPI) { if (wr == 1) PG8_BAR; }
    }
    PG8_WAIT_V(0);
    if constexpr (!ALIGN_EPI) { if (wr == 0) PG8_BAR; }
    PG8_BAR;
#undef PG8_SA
#undef PG8_SB
#undef PG8_STAGE
#undef PG8_LDA
#undef PG8_LDB
#undef PG8_MMA
#undef PG8_WAIT_V
#undef PG8_WAIT_L
#undef PG8_BAR
#undef PG8_SCHED
}
}

typedef unsigned short bf16;
typedef short bf16x8 __attribute__((ext_vector_type(8)));
typedef float f32x4 __attribute__((ext_vector_type(4)));
typedef float f32x16 __attribute__((ext_vector_type(16)));
typedef float f32x2 __attribute__((ext_vector_type(2)));
typedef __bf16 bf16x2v __attribute__((ext_vector_type(2)));
typedef unsigned u32x4 __attribute__((ext_vector_type(4)));
typedef unsigned u32x2 __attribute__((ext_vector_type(2)));
typedef _Float16 h4 __attribute__((ext_vector_type(4)));

constexpr int NB = 8, T = 4096, D = 1024, M = NB * T, NH = 8;
constexpr int ZMAIN = 3328, NGATE = 2048, DFF = 2816, NUP = 5632, PLED = 256;
constexpr float NORM_EPS = 1e-6f, GN_EPS = 64e-5f, LOG2E = 1.4426950408889634f, QSCALE = 0.125f * 1.4426950408889634f;
constexpr int NWAVES = 8, NTHR = 512;
constexpr int LDS_BYTES = 147456;
constexpr int REC = 768;

constexpr size_t MiB = (size_t)1 << 20;
constexpr size_t WS_SS2 = 0, WS_SS3 = 128 * 1024, WS_SSF = 256 * 1024, WS_BAR = 512 * 1024, WS_BT2 = 1 * MiB, CTL_BYTES = 2 * MiB;
constexpr size_t WS_WIN = 2 * MiB, WS_WUP = 13 * MiB, WS_WDOWN = 24 * MiB, WS_WO = 30 * MiB, WS_WBR = 32 * MiB, WS_WPG = 34 * MiB, WS_WPLE = 36 * MiB;
constexpr size_t WS_PB = 37 * MiB, WS_XB = 53 * MiB;
constexpr size_t WS_ZRM = 117 * MiB, WS_OAB = 117 * MiB, WS_U = 117 * MiB, WS_PL = 117 * MiB, WS_X3 = 181 * MiB;
constexpr size_t WS_QK = 213 * MiB, WS_GATES = 213 * MiB, WS_MERGED = 341 * MiB;
constexpr size_t WS_PACK = 277 * MiB, WS_V = 277 * MiB, WS_ZLOW = 309 * MiB;
constexpr size_t WS_BONUS = 501 * MiB, WS_END = 512 * MiB;
constexpr size_t O_A = 0, O_G = 32 * MiB, O_VT = 64 * MiB, O_Y = 96 * MiB, O_A2 = 96 * MiB;

__device__ __forceinline__ unsigned f2bf(float f) { unsigned u = __builtin_bit_cast(unsigned, f); return (u + 0x7fffu + ((u >> 16) & 1u)) >> 16; }
__device__ __forceinline__ unsigned pk2(float lo, float hi) { return f2bf(lo) | (f2bf(hi) << 16); }
__device__ __forceinline__ float bf2f(unsigned b) { return __builtin_bit_cast(float, b << 16); }
__device__ __forceinline__ float bflo(unsigned w) { return __builtin_bit_cast(float, w << 16); }
__device__ __forceinline__ float bfhi(unsigned w) { return __builtin_bit_cast(float, w & 0xffff0000u); }
__device__ __forceinline__ unsigned cvtpk(float lo, float hi) { f32x2 v = {lo, hi}; bf16x2v b = __builtin_convertvector(v, bf16x2v); return __builtin_bit_cast(unsigned, b); }
__device__ __forceinline__ unsigned short f2h(float f) { _Float16 h = (_Float16)f; return __builtin_bit_cast(unsigned short, h); }
__device__ __forceinline__ float wave_sum(float v) {
#pragma unroll
    for (int o = 1; o < 64; o <<= 1) v += __shfl_xor(v, o);
    return v;
}
__device__ __forceinline__ float sigmoidf_(float x) { return 1.f / (1.f + __expf(-x)); }
template <int CTRL> __device__ __forceinline__ float dpp_add(float x) { return x + __builtin_bit_cast(float, __builtin_amdgcn_update_dpp(0, __builtin_bit_cast(int, x), CTRL, 0xF, 0xF, true)); }
__device__ __forceinline__ float allreduce16(float x) { x = dpp_add<0xB1>(x); x = dpp_add<0x4E>(x); x = dpp_add<0x141>(x); x = dpp_add<0x140>(x); return x; }
#define MFMA32(a, b, c) __builtin_amdgcn_mfma_f32_32x32x16_bf16((a), (b), (c), 0, 0, 0)
__device__ __forceinline__ bf16x8 packstep(const f32x16& x, int s) {
    u32x4 w; w[0] = cvtpk(x[8 * s], x[8 * s + 1]); w[1] = cvtpk(x[8 * s + 2], x[8 * s + 3]); w[2] = cvtpk(x[8 * s + 4], x[8 * s + 5]); w[3] = cvtpk(x[8 * s + 6], x[8 * s + 7]);
    return __builtin_bit_cast(bf16x8, w);
}

using pg8::Unit; using pg8::cvt_pk_bf16;
#define EPI_TRAITS(mid) static constexpr bool PERM = true, AFTER_DRAIN = false, MID = mid;
#define EPI_ARGS const f32x4 (&acc)[2][2][4][2], const Unit& u, int wr, int wc, int fr, int fq
__device__ __forceinline__ u32x4 pack8(f32x4 v0, f32x4 v1) { u32x4 w; w.x = cvt_pk_bf16(v0[0], v0[1]); w.y = cvt_pk_bf16(v0[2], v0[3]); w.z = cvt_pk_bf16(v1[0], v1[1]); w.w = cvt_pk_bf16(v1[2], v1[3]); return w; }
__device__ __forceinline__ void unpack8(u32x4 w, f32x4& v0, f32x4& v1) { v0 = (f32x4){bflo(w.x), bfhi(w.x), bflo(w.y), bfhi(w.y)}; v1 = (f32x4){bflo(w.z), bfhi(w.z), bflo(w.w), bfhi(w.w)}; }

struct EpiZ { EPI_TRAITS(false)
    bf16 *ZRM, *ZLOW, *QK, *V;
    __device__ __forceinline__ void operator()(EPI_ARGS) const {
        const int colt = u.pn * 256; bf16* base; int ldc, c0; float sc = 1.f;
        if (colt < 1536) { base = ZRM; ldc = 1536; c0 = colt; }
        else if (colt < 1792) { base = ZLOW; ldc = 256; c0 = 0; }
        else if (colt < 2816) { base = QK; ldc = 1024; c0 = colt - 1792; if (c0 < 512) sc = QSCALE; }
        else { base = V; ldc = 512; c0 = colt - 2816; }
        const int col0 = c0 + wc * 32 + 8 * fq, row0 = u.pm * 256 + wr * 64 + fr;
#pragma unroll
        for (int ai = 0; ai < 2; ++ai)
#pragma unroll
            for (int m = 0; m < 4; ++m) { bf16* rowp = base + (size_t)(row0 + ai * 128 + m * 16) * ldc + col0;
#pragma unroll
                for (int bj = 0; bj < 2; ++bj) *(u32x4*)(rowp + bj * 128) = pack8(acc[ai][bj][m][0] * sc, acc[ai][bj][m][1] * sc); }
    }
};
struct EpiVT { EPI_TRAITS(false)
    bf16* VT;
    __device__ __forceinline__ void operator()(EPI_ARGS) const {
        const int col0 = u.pn * 256 + wc * 32 + 8 * fq, row0 = u.pm * 256 + wr * 64 + fr;
#pragma unroll
        for (int ai = 0; ai < 2; ++ai)
#pragma unroll
            for (int m = 0; m < 4; ++m) { const int r = row0 + ai * 128 + m * 16;
#pragma unroll
                for (int bj = 0; bj < 2; ++bj) { const int cc = col0 + bj * 128, b = cc / T, t = cc % T;
                    *(u32x4*)(VT + ((size_t)(b * 512 + r)) * T + t) = pack8(acc[ai][bj][m][0], acc[ai][bj][m][1]); } }
    }
};
struct EpiPlain { EPI_TRAITS(false)
    bf16* O; int ldc;
    __device__ __forceinline__ void operator()(EPI_ARGS) const {
        const int col0 = u.pn * 256 + wc * 32 + 8 * fq, row0 = u.pm * 256 + wr * 64 + fr;
#pragma unroll
        for (int ai = 0; ai < 2; ++ai)
#pragma unroll
            for (int m = 0; m < 4; ++m) { bf16* rowp = O + (size_t)(row0 + ai * 128 + m * 16) * ldc + col0;
#pragma unroll
                for (int bj = 0; bj < 2; ++bj) *(u32x4*)(rowp + bj * 128) = pack8(acc[ai][bj][m][0], acc[ai][bj][m][1]); }
    }
};
struct EpiLR { EPI_TRAITS(false)
    unsigned char* PACK; bf16* Aout; bf16* Gout; const float* w0; const float* a0;
    __device__ __forceinline__ void operator()(EPI_ARGS) const {
        const int colt = u.pn * 256, region = colt >> 9; const int row0 = u.pm * 256 + wr * 64 + fr;
#pragma unroll
        for (int bj = 0; bj < 2; ++bj) {
            const int c = (colt & 511) + bj * 128 + wc * 32 + 8 * fq;
            f32x4 p0 = {0.f, 0.f, 0.f, 0.f}, p1 = p0;
            if (region == 0) { p0 = *(const f32x4*)(w0 + c); p1 = *(const f32x4*)(w0 + c + 4); }
            else if (region == 1) { p0 = *(const f32x4*)(a0 + c); p1 = *(const f32x4*)(a0 + c + 4); }
#pragma unroll
            for (int ai = 0; ai < 2; ++ai)
#pragma unroll
                for (int m = 0; m < 4; ++m) {
                    const int row = row0 + ai * 128 + m * 16;
                    f32x4 v0 = acc[ai][bj][m][0] + p0, v1 = acc[ai][bj][m][1] + p1;
                    if (region == 0) {
#pragma unroll
                        for (int e = 0; e < 4; ++e) { v0[e] = __expf(-0.6065306597126334f * sigmoidf_(v0[e])); v1[e] = __expf(-0.6065306597126334f * sigmoidf_(v1[e])); }
                        const int b = row / T, t = row % T, h = c >> 6;
                        unsigned short* dst = (unsigned short*)(PACK + ((size_t)((b * NH + h) * T + t)) * REC + 640) + (c & 63);
                        u32x4 w_; w_.x = (unsigned)f2h(v0[0] - 1.f) | ((unsigned)f2h(v0[1] - 1.f) << 16); w_.y = (unsigned)f2h(v0[2] - 1.f) | ((unsigned)f2h(v0[3] - 1.f) << 16);
                        w_.z = (unsigned)f2h(v1[0] - 1.f) | ((unsigned)f2h(v1[1] - 1.f) << 16); w_.w = (unsigned)f2h(v1[2] - 1.f) | ((unsigned)f2h(v1[3] - 1.f) << 16);
                        *(u32x4*)dst = w_;
                    } else if (region == 1) {
#pragma unroll
                        for (int e = 0; e < 4; ++e) { v0[e] = sigmoidf_(v0[e]); v1[e] = sigmoidf_(v1[e]); }
                        *(u32x4*)(Aout + (size_t)row * 512 + c) = pack8(v0, v1);
                    } else {
                        *(u32x4*)(Gout + (size_t)row * 512 + c) = pack8(v0, v1);
                    }
                }
        }
    }
};
struct EpiGate { EPI_TRAITS(false)
    bf16* O; const float* bias;
    __device__ __forceinline__ void operator()(EPI_ARGS) const {
        const int ch0 = u.pn * 128 + wc * 32 + 8 * fq, colr = u.pn * 256 + wc * 32 + 8 * fq, row0 = u.pm * 256 + wr * 64 + fr;
        const f32x4 ba0 = *(const f32x4*)(bias + ch0), ba1 = *(const f32x4*)(bias + ch0 + 4), bb0 = *(const f32x4*)(bias + 1024 + ch0), bb1 = *(const f32x4*)(bias + 1024 + ch0 + 4);
#pragma unroll
        for (int ai = 0; ai < 2; ++ai)
#pragma unroll
            for (int m = 0; m < 4; ++m) {
                f32x4 a0 = acc[ai][0][m][0] + ba0, a1 = acc[ai][0][m][1] + ba1, b0 = acc[ai][1][m][0] + bb0, b1 = acc[ai][1][m][1] + bb1;
#pragma unroll
                for (int e = 0; e < 4; ++e) { b0[e] = fmaxf(sigmoidf_(b0[e]), 1e-30f); b1[e] = fmaxf(sigmoidf_(b1[e]), 1e-30f);
                    a0[e] = sigmoidf_(a0[e]) * __builtin_amdgcn_rcpf(b0[e]); a1[e] = sigmoidf_(a1[e]) * __builtin_amdgcn_rcpf(b1[e]); }
                bf16* rowp = O + (size_t)(row0 + ai * 128 + m * 16) * NGATE + colr;
                *(u32x4*)rowp = pack8(a0, a1); *(u32x4*)(rowp + 128) = pack8(b0, b1);
            }
    }
};
struct EpiMerge { EPI_TRAITS(true)
    const bf16* GATES; bf16* O;
    __device__ __forceinline__ void mid(f32x4 (&acc)[2][2][4][2], const Unit& u, int wr, int wc, int fr, int fq) const {
        const int gcol = u.pn * 512 + wc * 32 + 8 * fq, row0 = u.pm * 256 + wr * 64 + fr;
#pragma unroll
        for (int ai = 0; ai < 2; ++ai) {
            u32x4 gr[4][2];
#pragma unroll
            for (int m = 0; m < 4; ++m) {
                int row_ = row0 + ai * 128 + m * 16; asm volatile("" : "+v"(row_));
#pragma unroll
                for (int bj = 0; bj < 2; ++bj) gr[m][bj] = *(const u32x4*)(GATES + (size_t)row_ * NGATE + gcol + bj * 256);
            }
            __builtin_amdgcn_sched_barrier(0);
#pragma unroll
            for (int m = 0; m < 4; ++m)
#pragma unroll
                for (int bj = 0; bj < 2; ++bj) { f32x4 r0, r1; unpack8(gr[m][bj], r0, r1); acc[ai][bj][m][0] *= r0; acc[ai][bj][m][1] *= r1; }
            __builtin_amdgcn_sched_barrier(0);
        }
    }
    __device__ __forceinline__ void operator()(EPI_ARGS) const {
        const int col0 = u.pn * 256 + wc * 32 + 8 * fq, gcol = u.pn * 512 + wc * 32 + 8 * fq + 128, row0 = u.pm * 256 + wr * 64 + fr;
#pragma unroll
        for (int ai = 0; ai < 2; ++ai)
#pragma unroll
            for (int m = 0; m < 4; ++m)
#pragma unroll
                for (int bj = 0; bj < 2; ++bj) {
                    int row_ = row0 + ai * 128 + m * 16; asm volatile("" : "+v"(row_)); const size_t row = (size_t)row_;
                    f32x4 b0, b1; unpack8(*(const u32x4*)(GATES + row * NGATE + gcol + bj * 256), b0, b1);
                    *(u32x4*)(O + row * D + col0 + bj * 128) = pack8(acc[ai][bj][m][0] * b0, acc[ai][bj][m][1] * b1);
                    if (bj == 1 && (m & 1)) __builtin_amdgcn_sched_barrier(0);
                }
    }
};
struct EpiRes { EPI_TRAITS(false)
    const float* base; bf16* XB; float* SS; int dost;
    __device__ __forceinline__ void operator()(EPI_ARGS) const {
        const int col0 = u.pn * 256 + wc * 32 + 8 * fq, row0 = u.pm * 256 + wr * 64 + fr;
#pragma unroll
        for (int ai = 0; ai < 2; ++ai)
#pragma unroll
            for (int m = 0; m < 4; ++m) {
                const size_t row = (size_t)(row0 + ai * 128 + m * 16); float ss = 0.f;
#pragma unroll
                for (int bj = 0; bj < 2; ++bj) {
                    const size_t o = row * D + col0 + bj * 128;
                    f32x4 v0 = *(const f32x4*)(base + o) + acc[ai][bj][m][0], v1 = *(const f32x4*)(base + o + 4) + acc[ai][bj][m][1];
                    if (dost) *(u32x4*)(XB + o) = pack8(v0, v1);
#pragma unroll
                    for (int e = 0; e < 4; ++e) ss += v0[e] * v0[e] + v1[e] * v1[e];
                }
                ss += __shfl_xor(ss, 16); ss += __shfl_xor(ss, 32);
                if (fq == 0 && dost) atomicAdd(SS + row, ss);
            }
    }
};
struct EpiResB { EPI_TRAITS(false)
    bf16* XB; float* SS; int dost;
    __device__ __forceinline__ void operator()(EPI_ARGS) const {
        const int col0 = u.pn * 256 + wc * 32 + 8 * fq, row0 = u.pm * 256 + wr * 64 + fr;
#pragma unroll
        for (int ai = 0; ai < 2; ++ai)
#pragma unroll
            for (int m = 0; m < 4; ++m) {
                const size_t row = (size_t)(row0 + ai * 128 + m * 16); float ss = 0.f;
#pragma unroll
                for (int bj = 0; bj < 2; ++bj) {
                    const size_t o = row * D + col0 + bj * 128;
                    f32x4 b0, b1; unpack8(*(const u32x4*)(XB + o), b0, b1);
                    f32x4 v0 = b0 + acc[ai][bj][m][0], v1 = b1 + acc[ai][bj][m][1];
                    if (dost) *(u32x4*)(XB + o) = pack8(v0, v1);
#pragma unroll
                    for (int e = 0; e < 4; ++e) ss += v0[e] * v0[e] + v1[e] * v1[e];
                }
                ss += __shfl_xor(ss, 16); ss += __shfl_xor(ss, 32);
                if (fq == 0 && dost) atomicAdd(SS + row, ss);
            }
    }
};
struct EpiUp { EPI_TRAITS(false)
    bf16* O; const float* SS;
    __device__ __forceinline__ void operator()(EPI_ARGS) const {
        const int col0 = u.pn * 256 + wc * 32 + 8 * fq, row0 = u.pm * 256 + wr * 64 + fr;
#pragma unroll
        for (int ai = 0; ai < 2; ++ai)
#pragma unroll
            for (int m = 0; m < 4; ++m) {
                const size_t row = (size_t)(row0 + ai * 128 + m * 16); const float rs = rsqrtf(SS[row] * (1.f / D) + NORM_EPS);
#pragma unroll
                for (int bj = 0; bj < 2; ++bj) *(u32x4*)(O + row * NUP + col0 + bj * 128) = pack8(acc[ai][bj][m][0] * rs, acc[ai][bj][m][1] * rs);
            }
    }
};
template <int CTRL> __device__ __forceinline__ float dpp_mov_f(float oldv, float x) { return __builtin_bit_cast(float, __builtin_amdgcn_update_dpp(__builtin_bit_cast(int, oldv), __builtin_bit_cast(int, x), CTRL, 0xF, 0xF, false)); }
struct EpiUpAct { EPI_TRAITS(false)
    bf16* O; const float* SS; const float* cw; const float* cb;
    __device__ __forceinline__ void operator()(EPI_ARGS) const {
        const int colb = u.pn * 256 + wc * 32 + 8 * fq, ch0 = u.pn * 128 + wc * 32 + 8 * fq, row0 = u.pm * 256 + wr * 64 + fr;
        f32x4 W0[2], W1[2], W2[2], CB[2];
#pragma unroll
        for (int n = 0; n < 2; ++n) { W0[n] = *(const f32x4*)(cw + ch0 + 4 * n); W1[n] = *(const f32x4*)(cw + DFF + ch0 + 4 * n); W2[n] = *(const f32x4*)(cw + 2 * DFF + ch0 + 4 * n); CB[n] = *(const f32x4*)(cb + ch0 + 4 * n); }
#pragma unroll
        for (int ai = 0; ai < 2; ++ai) {
            f32x4 pv[2] = {{0.f, 0.f, 0.f, 0.f}, {0.f, 0.f, 0.f, 0.f}};
#pragma unroll
            for (int m = 0; m < 4; ++m) {
                int row_ = row0 + ai * 128 + m * 16; asm volatile("" : "+v"(row_)); const size_t row = (size_t)row_;
                const float rs = rsqrtf(SS[row] * (1.f / D) + NORM_EPS);
                f32x4 cur[2] = {acc[ai][0][m][0] * rs, acc[ai][0][m][1] * rs}, gv[2] = {acc[ai][1][m][0] * rs, acc[ai][1][m][1] * rs}, r[2];
#pragma unroll
                for (int n = 0; n < 2; ++n)
#pragma unroll
                    for (int e = 0; e < 4; e += 2) {
                        f32x2 cv;
                        { const float c_ = cur[n][e], p_ = pv[n][e]; const float p1 = dpp_mov_f<0x111>(dpp_mov_f<0x121>(0.f, p_), c_), p2 = dpp_mov_f<0x112>(dpp_mov_f<0x122>(0.f, p_), c_);
                          cv.x = CB[n][e] + W0[n][e] * p2 + W1[n][e] * p1 + W2[n][e] * c_; }
                        { const float c_ = cur[n][e + 1], p_ = pv[n][e + 1]; const float p1 = dpp_mov_f<0x111>(dpp_mov_f<0x121>(0.f, p_), c_), p2 = dpp_mov_f<0x112>(dpp_mov_f<0x122>(0.f, p_), c_);
                          cv.y = CB[n][e + 1] + W0[n][e + 1] * p2 + W1[n][e + 1] * p1 + W2[n][e + 1] * c_; }
                        const f32x2 ge = pg8::gelu_pk(cv); r[n][e] = ge.x * gv[n][e]; r[n][e + 1] = ge.y * gv[n][e + 1];
                    }
                const bool rawrow = (m == 0) && (fr < 2);
                if ((m == 0 && fr < 2) || (m == 3 && fr >= 14)) { const int rl = row_ & 63, slot = 4 * (row_ >> 6) + (rl < 2 ? rl : rl - 60);
                    *(u32x4*)(O + (size_t)M * DFF + (size_t)slot * DFF + ch0) = pack8(cur[0], cur[1]); }
                *(u32x4*)(O + row * DFF + ch0) = rawrow ? pack8(gv[0], gv[1]) : pack8(r[0], r[1]);
                pv[0] = cur[0]; pv[1] = cur[1];
                __builtin_amdgcn_sched_barrier(0);
            }
        }
    }
};
struct EpiFinal { EPI_TRAITS(false)
    bf16* X3; const bf16* XB; const bf16* PL; const float* SS3; const float* bias; float* SSF; int dost;
    __device__ __forceinline__ void operator()(EPI_ARGS) const {
        const int col0 = u.pn * 256 + wc * 32 + 8 * fq, row0 = u.pm * 256 + wr * 64 + fr;
        f32x4 bb[2][2];
#pragma unroll
        for (int bj = 0; bj < 2; ++bj) { bb[bj][0] = *(const f32x4*)(bias + col0 + bj * 128); bb[bj][1] = *(const f32x4*)(bias + col0 + bj * 128 + 4); }
#pragma unroll
        for (int ai = 0; ai < 2; ++ai)
#pragma unroll
            for (int m = 0; m < 4; ++m) {
                const size_t row = (size_t)(row0 + ai * 128 + m * 16); const float rs = rsqrtf(SS3[row] * (1.f / D) + NORM_EPS); float ss = 0.f;
#pragma unroll
                for (int bj = 0; bj < 2; ++bj) {
                    const size_t o = row * D + col0 + bj * 128;
                    f32x4 p0, p1; unpack8(*(const u32x4*)(PL + o), p0, p1);
                    f32x4 g0 = acc[ai][bj][m][0] * rs + bb[bj][0], g1 = acc[ai][bj][m][1] * rs + bb[bj][1];
#pragma unroll
                    for (int e = 0; e < 4; ++e) { g0[e] = sigmoidf_(g0[e]); g1[e] = sigmoidf_(g1[e]); }
                    f32x4 x0, x1; unpack8(*(const u32x4*)(XB + o), x0, x1);
                    f32x4 v0 = x0 + p0 * g0, v1 = x1 + p1 * g1;
                    if (dost) *(u32x4*)(X3 + o) = pack8(v0, v1);
#pragma unroll
                    for (int e = 0; e < 4; ++e) ss += v0[e] * v0[e] + v1[e] * v1[e];
                }
                ss += __shfl_xor(ss, 16); ss += __shfl_xor(ss, 32);
                if (fq == 0 && dost) atomicAdd(SSF + row, ss);
            }
    }
};

#define XB_TMO      128
#define XB_XCNT(j)  (256  + 64 * (j))
#define XB_XSUB(j)  (1280 + 64 * (j))
#define XB_XGEN(j)  (2304 + 64 * (j))
#define XB_TOP      3328
#define XB_TOPGEN   3392
#define XCD_BAR_WORDS 3456
#define XB_SPIN_CAP (1u << 18)

__device__ __forceinline__ unsigned xb_ld(unsigned* p)              { return __hip_atomic_load(p, __ATOMIC_RELAXED, __HIP_MEMORY_SCOPE_AGENT); }
__device__ __forceinline__ unsigned xb_add(unsigned* p, unsigned v) { return __hip_atomic_fetch_add(p, v, __ATOMIC_RELAXED, __HIP_MEMORY_SCOPE_AGENT); }
__device__ __forceinline__ unsigned xb_xcc_id() { return (unsigned)__builtin_amdgcn_s_getreg((3 << 11) | 20) & 0xFu; }
#define XB_SPIN(cond, bar) do { unsigned _sp = 0; while (cond) { __builtin_amdgcn_s_sleep(1); \
    if ((++_sp & 255u) == 0u) { if (xb_ld(&(bar)[XB_TMO])) break; if (_sp > XB_SPIN_CAP) { atomicAdd(&(bar)[XB_TMO], 1u); break; } } } } while (0)

struct XcdBarrier {
    unsigned* bar; unsigned x;
    volatile __attribute__((address_space(3))) unsigned* st;
};

__device__ __forceinline__ XcdBarrier xcd_barrier_post(unsigned* bar, volatile __attribute__((address_space(3))) unsigned* st) {
    XcdBarrier b; b.bar = bar; b.x = xb_xcc_id(); b.st = st;
    if (threadIdx.x == 0) (void)xb_add(&bar[XB_XCNT(b.x)], 1u);
    return b;
}
__device__ __forceinline__ void xcd_barrier_complete(unsigned* bar, unsigned x, unsigned& nloc, unsigned& nx) {
    const unsigned G = gridDim.x * gridDim.y * gridDim.z;
    unsigned sum, cnt, mine, sp = 0u;
    for (;;) {
        sum = 0u; cnt = 0u; mine = 0u;
#pragma unroll
        for (unsigned j = 0; j < 16; ++j) { const unsigned c = xb_ld(&bar[XB_XCNT(j)]); sum += c; cnt += (c > 0u) ? 1u : 0u; mine = (j == x) ? c : mine; }
        if (sum == G) break;
        __builtin_amdgcn_s_sleep(1);
        if ((++sp & 255u) == 0u) { if (xb_ld(&bar[XB_TMO])) break; if (sp > XB_SPIN_CAP) { atomicAdd(&bar[XB_TMO], 1u); break; } }
    }
    nloc = mine > 0u ? mine : 1u; nx = cnt > 0u ? cnt : 1u;
}

__device__ __forceinline__ void xcd_barrier(const XcdBarrier& b, int tid_) {
    asm volatile("s_waitcnt vmcnt(0)" ::: "memory");
    __syncthreads();
    if (tid_ == 0) {
        unsigned* bar = b.bar;
        __builtin_amdgcn_s_waitcnt(0);
        unsigned nloc = b.st[0], nx = b.st[1];
        if (nloc == 0u) { xcd_barrier_complete(bar, b.x, nloc, nx); b.st[0] = nloc; b.st[1] = nx; }
        const unsigned old = xb_add(&bar[XB_XSUB(b.x)], 1u);
        const unsigned gen = old / nloc;
        if (old + 1u == (gen + 1u) * nloc) {
            __builtin_amdgcn_fence(__ATOMIC_RELEASE, "agent");
            asm volatile("s_waitcnt vmcnt(0)" ::: "memory");
            const unsigned og = xb_add(&bar[XB_TOP], 1u);
            const unsigned tg = og / nx;
            if (og + 1u == (tg + 1u) * nx) xb_add(&bar[XB_TOPGEN], 1u);
            else XB_SPIN(xb_ld(&bar[XB_TOPGEN]) == tg, bar);
            __builtin_amdgcn_fence(__ATOMIC_ACQUIRE, "agent");
            xb_add(&bar[XB_XGEN(b.x)], 1u);
            asm volatile("s_waitcnt vmcnt(0)" ::: "memory");
        } else {
            XB_SPIN(xb_ld(&bar[XB_XGEN(b.x)]) == gen, bar);
            __builtin_amdgcn_fence(__ATOMIC_ACQUIRE, "agent");
            asm volatile("s_waitcnt vmcnt(0)" ::: "memory");
        }
    }
    __syncthreads();
}

struct Ctx { unsigned char* lds; int tid, lane, wave, G, gw, NGW; };
__device__ __forceinline__ int vlane_id() { int l; asm volatile("v_mbcnt_lo_u32_b32 %0, -1, 0\n\tv_mbcnt_hi_u32_b32 %0, -1, %0" : "=v"(l)); return l; }

template <int KT>
__device__ __forceinline__ void p0_transpose_item(const float* W, int K, int N, bf16* WT, int ldk, int koff, int row_off, int upperm  , const float* gain, float* scr, int item, int lane, int nb_lo = 0, int nb_cnt = 0) {
    constexpr int CPR = KT / 8, NPI = 64 / CPR;
    const int nblk = nb_cnt ? nb_cnt : N / 32, kb = item / nblk, nb = nb_lo + item % nblk, k0 = KT * kb, n0 = 32 * nb;
#pragma unroll
    for (int i = 0; i < KT / 2; ++i) { const int kk = 2 * i + (lane >> 5); float v = W[(size_t)(k0 + kk) * N + n0 + (lane & 31)]; if (gain) v *= gain[k0 + kk]; scr[kk * 33 + (lane & 31)] = v; }
    asm volatile("s_waitcnt lgkmcnt(0)" ::: "memory");
    const int c = lane % CPR;
#pragma unroll
    for (int j = 0; j < 32 / NPI; ++j) { const int n = (lane / CPR) + NPI * j; const float* s = scr + (8 * c) * 33 + n;
        u32x4 o; o.x = pk2(s[0 * 33], s[1 * 33]); o.y = pk2(s[2 * 33], s[3 * 33]); o.z = pk2(s[4 * 33], s[5 * 33]); o.w = pk2(s[6 * 33], s[7 * 33]);
        const int ncol = n0 + n; int drow = row_off + ncol;
        if (upperm == 1) { const int half = ncol >= DFF ? 1 : 0, ch = ncol - half * DFF; drow = 256 * (ch >> 7) + 128 * half + (ch & 127); }
        if (upperm == 2) { const int jg = ncol - ZMAIN, half = jg >= 1024 ? 1 : 0, ch = jg - half * 1024; drow = ZMAIN + 256 * (ch >> 7) + 128 * half + (ch & 127); }
        *(u32x4*)(WT + (size_t)drow * ldk + koff + k0 + 8 * c) = o; }
    asm volatile("s_waitcnt lgkmcnt(0)" ::: "memory");
}

struct P { const float* in[30]; float* out; unsigned char* ws; int ph_lo, ph_hi; };
enum { I_X = 0, I_P, I_LN1, I_WIN, I_MU, I_W0, I_W2, I_A0, I_A2, I_G2, I_KK, I_KA, I_RK, I_LNXW, I_LNXB, I_REL, I_GATEB, I_WBRR, I_WBRA, I_WO, I_LN2, I_WUP, I_CONVW, I_CONVB, I_WDOWN, I_LN3, I_WPLE, I_WPG, I_BPG, I_LNF };

__device__ __forceinline__ void phase0(const P& p, const Ctx& c) {
    float* scr = (float*)(c.lds + c.wave * 16384);
    unsigned char* ws = p.ws;
    constexpr int I1 = 16 * 104, I9 = 16, I10 = 16, I11 = 32;
    constexpr int NITEMS = I1 + I9 + I10 + I11;
    for (int it = c.gw; it < NITEMS; it += c.NGW) {
        int r = it;
        if (r < I1) { p0_transpose_item<64>(p.in[I_WIN], D, 5376, (bf16*)(ws + WS_WIN), D, 0, 0, false, p.in[I_LN1], scr, r, c.lane, 0, 104); continue; } r -= I1;
        if (r < I9) { p0_transpose_item<64>(p.in[I_W2], 64, 512, (bf16*)(ws + WS_BT2), 256, 0, 0, false, nullptr, scr, r, c.lane); continue; } r -= I9;
        if (r < I10) { p0_transpose_item<64>(p.in[I_A2], 64, 512, (bf16*)(ws + WS_BT2), 256, 64, 512, false, nullptr, scr, r, c.lane); continue; } r -= I10;
        p0_transpose_item<64>(p.in[I_G2], 128, 512, (bf16*)(ws + WS_BT2), 256, 128, 1024, false, nullptr, scr, r, c.lane);
    }
    const float* x = p.in[I_X]; bf16* H1 = (bf16*)(ws + WS_XB);
    for (int m = c.gw; m < M; m += 4 * c.NGW) {
        f32x4 v[4][4]; float sq[4];
#pragma unroll
        for (int r = 0; r < 4; ++r) { const f32x4* xr = (const f32x4*)(x + (size_t)(m + r * c.NGW) * D) + c.lane;
#pragma unroll
            for (int j = 0; j < 4; ++j) v[r][j] = __builtin_nontemporal_load(xr + 64 * j); }
#pragma unroll
        for (int r = 0; r < 4; ++r) { float s = 0.f;
#pragma unroll
            for (int j = 0; j < 4; ++j) s += (v[r][j].x * v[r][j].x + v[r][j].y * v[r][j].y) + (v[r][j].z * v[r][j].z + v[r][j].w * v[r][j].w);
            sq[r] = s; }
#pragma unroll
        for (int o = 1; o < 64; o <<= 1) {
#pragma unroll
            for (int r = 0; r < 4; ++r) sq[r] += __shfl_xor(sq[r], o); }
#pragma unroll
        for (int r = 0; r < 4; ++r) { const float rs = rsqrtf(sq[r] * (1.f / D) + NORM_EPS); u32x2* o8 = (u32x2*)(H1 + (size_t)(m + r * c.NGW) * D) + c.lane;
#pragma unroll
            for (int j = 0; j < 4; ++j) { u32x2 o; o.x = pk2(v[r][j].x * rs, v[r][j].y * rs); o.y = pk2(v[r][j].z * rs, v[r][j].w * rs); o8[64 * j] = o; } }
    }
}

__device__ __forceinline__ void phase2a(const P& p, const Ctx& c) {
    unsigned char* ws = p.ws;
    const bf16* ZLOW = (const bf16*)(ws + WS_ZLOW); bf16* A2 = (bf16*)((unsigned char*)p.out + O_A2);
    const f32x4 mu = *(const f32x4*)(p.in[I_MU] + 1536 + 4 * c.lane);
    for (int m = c.gw; m < M; m += c.NGW) {
        const u32x2 z = *(const u32x2*)(ZLOW + (size_t)m * 256 + 4 * c.lane);
        u32x2 zp = {0u, 0u}; if ((m & (T - 1)) != 0) zp = *(const u32x2*)(ZLOW + (size_t)(m - 1) * 256 + 4 * c.lane);
        float v[4] = {bflo(z.x), bfhi(z.x), bflo(z.y), bfhi(z.y)}; const float q[4] = {bflo(zp.x), bfhi(zp.x), bflo(zp.y), bfhi(zp.y)};
#pragma unroll
        for (int e = 0; e < 4; ++e) { v[e] = v[e] + (q[e] - v[e]) * mu[e];
            if (c.lane < 16) v[e] = 1.f - 2.f / (1.f + __expf(2.f * v[e])); else if (c.lane >= 32) v[e] = sigmoidf_(v[e]); }
        u32x2 o; o.x = pk2(v[0], v[1]); o.y = pk2(v[2], v[3]); *(u32x2*)(A2 + (size_t)m * 256 + 4 * c.lane) = o;
    }
}

__device__ __forceinline__ unsigned h2pack(float a, float b) { return (unsigned)f2h(a) | ((unsigned)f2h(b) << 16); }
__device__ __forceinline__ void phase2c(const P& p, const Ctx& c) {
    unsigned char* ws = p.ws;
    const bf16* ZRM = (const bf16*)(ws + WS_ZRM); const bf16* A = (const bf16*)((unsigned char*)p.out + O_A);
    unsigned char* PACK = ws + WS_PACK; float* BONUS = (float*)(ws + WS_BONUS);
    const int hq = c.lane >> 4, js = c.lane & 15;
    for (int wi = c.gw; wi < 2048; wi += c.NGW) {
        const int hh = wi & 1, chunk = wi >> 1, h = 4 * hh + hq, col = h * 64 + 4 * js; const int mb = chunk * 32;
        const f32x4 mur = *(const f32x4*)(p.in[I_MU] + col), muk = *(const f32x4*)(p.in[I_MU] + 512 + col), muv = *(const f32x4*)(p.in[I_MU] + 1024 + col);
        const f32x4 kkw = *(const f32x4*)(p.in[I_KK] + col), kaw = *(const f32x4*)(p.in[I_KA] + col), rkw = *(const f32x4*)(p.in[I_RK] + col);
        f32x4 pr = {0.f, 0.f, 0.f, 0.f}, pk = pr, pv = pr;
        if ((mb & (T - 1)) != 0) { const bf16* z = ZRM + (size_t)(mb - 1) * 1536 + col; const u32x2 a_ = *(const u32x2*)z, b_ = *(const u32x2*)(z + 512), c_ = *(const u32x2*)(z + 1024);
            pr = (f32x4){bflo(a_.x), bfhi(a_.x), bflo(a_.y), bfhi(a_.y)}; pk = (f32x4){bflo(b_.x), bfhi(b_.x), bflo(b_.y), bfhi(b_.y)}; pv = (f32x4){bflo(c_.x), bfhi(c_.x), bflo(c_.y), bfhi(c_.y)}; }
        const int b = mb / T, t0 = mb % T;
        unsigned char* rec = PACK + ((size_t)((b * NH + h) * T + t0)) * REC + 8 * js;
#pragma unroll 8
        for (int i = 0; i < 32; ++i) {
            const int m = mb + i; const bf16* z = ZRM + (size_t)m * 1536 + col;
            const u32x2 a_ = *(const u32x2*)z, b_ = *(const u32x2*)(z + 512), c_ = *(const u32x2*)(z + 1024), d_ = *(const u32x2*)(A + (size_t)m * 512 + col);
            const f32x4 zr = {bflo(a_.x), bfhi(a_.x), bflo(a_.y), bfhi(a_.y)}, zk = {bflo(b_.x), bfhi(b_.x), bflo(b_.y), bfhi(b_.y)}, zv = {bflo(c_.x), bfhi(c_.x), bflo(c_.y), bfhi(c_.y)}, av = {bflo(d_.x), bfhi(d_.x), bflo(d_.y), bfhi(d_.y)};
            const f32x4 r = zr + (pr - zr) * mur, k = zk + (pk - zk) * muk, v = zv + (pv - zv) * muv; pr = zr; pk = zk; pv = zv;
            const f32x4 kkv = k * kkw; const float ss = allreduce16((kkv.x * kkv.x + kkv.y * kkv.y) + (kkv.z * kkv.z + kkv.w * kkv.w));
            const f32x4 kk = kkv * (1.f / fmaxf(sqrtf(ss), 1e-12f));
            const f32x4 kp = k * (1.f + (av - 1.f) * kaw), bb = kk * av, rb = r * kp * rkw;
            const float bon = allreduce16((rb.x + rb.y) + (rb.z + rb.w));
            unsigned char* q = rec + (size_t)i * REC;
            u32x2 o; o.x = h2pack(-kk.x, -kk.y); o.y = h2pack(-kk.z, -kk.w); *(u32x2*)q = o;
            o.x = h2pack(bb.x, bb.y); o.y = h2pack(bb.z, bb.w); *(u32x2*)(q + 128) = o;
            o.x = h2pack(kp.x, kp.y); o.y = h2pack(kp.z, kp.w); *(u32x2*)(q + 256) = o;
            o.x = h2pack(r.x, r.y); o.y = h2pack(r.z, r.w); *(u32x2*)(q + 384) = o;
            o.x = h2pack(v.x, v.y); o.y = h2pack(v.z, v.w); *(u32x2*)(q + 512) = o;
            if (js == 0) BONUS[(size_t)m * NH + h] = bon;
        }
    }
}

typedef _Float16 h2t __attribute__((ext_vector_type(2)));
__device__ __forceinline__ float mixz_lo(unsigned h, float b) { float d; asm("v_fma_mix_f32 %0, %1, %2, 0 op_sel:[0,0,0] op_sel_hi:[1,0,0]" : "=v"(d) : "v"(h), "v"(b)); return d; }
__device__ __forceinline__ float mix_lo(unsigned h, float b, float c) { float d; asm("v_fma_mix_f32 %0, %1, %2, %3 op_sel:[0,0,0] op_sel_hi:[1,0,0]" : "=v"(d) : "v"(h), "v"(b), "v"(c)); return d; }
__device__ __forceinline__ float mix_hi(unsigned h, float b, float c) { float d; asm("v_fma_mix_f32 %0, %1, %2, %3 op_sel:[1,0,0] op_sel_hi:[1,0,0]" : "=v"(d) : "v"(h), "v"(b), "v"(c)); return d; }
__device__ __forceinline__ float mix2z_ll(unsigned h, unsigned g) { float d; asm("v_fma_mix_f32 %0, %1, %2, 0 op_sel:[0,0,0] op_sel_hi:[1,1,0]" : "=v"(d) : "v"(h), "v"(g)); return d; }
__device__ __forceinline__ float mix2z_lh(unsigned h, unsigned g) { float d; asm("v_fma_mix_f32 %0, %1, %2, 0 op_sel:[0,1,0] op_sel_hi:[1,1,0]" : "=v"(d) : "v"(h), "v"(g)); return d; }
#define CHB 6144
#define SC_G(chsrc, buf) do { const unsigned char* _g = src + (size_t)(chsrc) * CHB + lane * 16; \
        if (dodma) _Pragma("unroll") for (int _i = 0; _i < 6; ++_i) __builtin_amdgcn_global_load_lds((const unsigned*)(_g + _i * 1024), (PG8_LAS unsigned*)(ldsw + (buf) * CHB + _i * 1024), 16, 0, 0); } while (0)
#define SC_RD(X, buf, i) do { const int _o = (buf) * CHB + (i) * REC; nk##X = *(const PG8_LAS u32x2*)(pj + _o); bq##X = *(const PG8_LAS u32x2*)(pj + _o + 128); rq##X = *(const PG8_LAS u32x2*)(pj + _o + 384); \
        nd##X = *(const PG8_LAS u32x2*)(pj + _o + 640); } while (0)
#define SC_RDK(X, buf, i) do { const int _o = (buf) * CHB + (i) * REC; kq##X = *(const PG8_LAS u32x2*)(pj + _o + 256); vh##X = *(const PG8_LAS unsigned short*)(pv + _o); } while (0)
#ifdef PROBE_EXTRA
#define SC_EXTRA "v_fma_mix_f32 %[q], %[ry], %[s2], 0 op_sel:[0,0,0] op_sel_hi:[1,0,0]\n\tv_fma_mix_f32 %[q], %[ry], %[s3], %[q] op_sel:[1,0,0] op_sel_hi:[1,0,0]\n\tv_fma_mix_f32 %[q], %[ry], %[s2], 0 op_sel:[0,0,0] op_sel_hi:[1,0,0]\n\tv_fma_mix_f32 %[q], %[ry], %[s3], %[q] op_sel:[1,0,0] op_sel_hi:[1,0,0]\n\tv_fma_mix_f32 %[q], %[ry], %[s2], 0 op_sel:[0,0,0] op_sel_hi:[1,0,0]\n\tv_fma_mix_f32 %[q], %[ry], %[s3], %[q] op_sel:[1,0,0] op_sel_hi:[1,0,0]\n\tv_fma_mix_f32 %[q], %[ry], %[s2], 0 op_sel:[0,0,0] op_sel_hi:[1,0,0]\n\tv_fma_mix_f32 %[q], %[ry], %[s3], %[q] op_sel:[1,0,0] op_sel_hi:[1,0,0]\n\t"
#else
#define SC_EXTRA
#endif
#define DPPM " row_mask:0xf bank_mask:0xf bound_ctrl:1\n\t"
#define SC_CP(X, par, i, Y, nbuf, ni, kbuf, ki) do { \
        float p_, q_, n0_, n1_, n2_, n3_; \
        asm volatile( \
            "v_fma_mix_f32 %[p], %[nkx], %[s0], 0 op_sel:[0,0,0] op_sel_hi:[1,0,0]\n\t" \
            "v_fma_mix_f32 %[q], %[nky], %[s2], 0 op_sel:[0,0,0] op_sel_hi:[1,0,0]\n\t" \
            "v_add_f32_dpp %[yr], %[yr], %[yr] quad_perm:[1,0,3,2]" DPPM \
            "v_fma_mix_f32 %[p], %[nkx], %[s1], %[p] op_sel:[1,0,0] op_sel_hi:[1,0,0]\n\t" \
            "v_fma_mix_f32 %[q], %[nky], %[s3], %[q] op_sel:[1,0,0] op_sel_hi:[1,0,0]\n\t" \
            "v_add_f32_dpp %[yr], %[yr], %[yr] quad_perm:[2,3,0,1]" DPPM \
            "v_add_f32_e32 %[p], %[p], %[q]\n\t" \
            "s_nop 0\n\t" \
            "v_add_f32_dpp %[yr], %[yr], %[yr] row_half_mirror" DPPM \
            "v_add_f32_dpp %[p], %[p], %[p] quad_perm:[1,0,3,2]" DPPM \
            : [p] "=&v"(p_), [q] "=&v"(q_), [yr] "+v"(yq) \
            : [nkx] "v"(nk##X.x), [nky] "v"(nk##X.y), [s0] "v"(S0), [s1] "v"(S1), [s2] "v"(S2), [s3] "v"(S3)); \
        __builtin_amdgcn_sched_barrier(0); SC_RD(Y, nbuf, ni); SC_RDK(X, kbuf, ki); __builtin_amdgcn_sched_barrier(0); \
        asm volatile( \
            "v_fma_mix_f32 %[n0], %[vh], %[kx], 0 op_sel:[0,0,0] op_sel_hi:[1,1,0]\n\t" \
            "v_add_f32_dpp %[yr], %[yr], %[yr] row_mirror" DPPM \
            "v_add_f32_dpp %[p], %[p], %[p] quad_perm:[2,3,0,1]" DPPM \
            "v_fma_mix_f32 %[n1], %[vh], %[kx], 0 op_sel:[0,1,0] op_sel_hi:[1,1,0]\n\t" \
            "v_fma_mix_f32 %[n2], %[vh], %[ky], 0 op_sel:[0,0,0] op_sel_hi:[1,1,0]\n\t" \
            "v_add_f32_dpp %[p], %[p], %[p] row_half_mirror" DPPM \
            "v_fma_mix_f32 %[n3], %[vh], %[ky], 0 op_sel:[0,1,0] op_sel_hi:[1,1,0]\n\t" \
            "s_nop 0\n\t" \
            "v_add_f32_dpp %[p], %[p], %[p] row_mirror" DPPM \
            "v_fma_mix_f32 %[t0], %[bx], %[p], %[t0] op_sel:[0,0,0] op_sel_hi:[1,0,0]\n\t" \
            "v_fma_mix_f32 %[t1], %[bx], %[p], %[t1] op_sel:[1,0,0] op_sel_hi:[1,0,0]\n\t" \
            "v_fma_mix_f32 %[t2], %[by], %[p], %[t2] op_sel:[0,0,0] op_sel_hi:[1,0,0]\n\t" \
            "v_fma_mix_f32 %[t3], %[by], %[p], %[t3] op_sel:[1,0,0] op_sel_hi:[1,0,0]\n\t" \
            "v_add_f32_e32 %[t0], %[t0], %[s0]\n\t" \
            "v_add_f32_e32 %[t1], %[t1], %[s1]\n\t" \
            "v_add_f32_e32 %[t2], %[t2], %[s2]\n\t" \
            "v_add_f32_e32 %[t3], %[t3], %[s3]\n\t" \
            "v_fma_mix_f32 %[s0], %[ndx], %[s0], %[t0] op_sel:[0,0,0] op_sel_hi:[1,0,0]\n\t" \
            "v_fma_mix_f32 %[s1], %[ndx], %[s1], %[t1] op_sel:[1,0,0] op_sel_hi:[1,0,0]\n\t" \
            "v_fma_mix_f32 %[s2], %[ndy], %[s2], %[t2] op_sel:[0,0,0] op_sel_hi:[1,0,0]\n\t" \
            "v_fma_mix_f32 %[s3], %[ndy], %[s3], %[t3] op_sel:[1,0,0] op_sel_hi:[1,0,0]\n\t" \
            "v_fma_mix_f32 %[p], %[rx], %[s0], 0 op_sel:[0,0,0] op_sel_hi:[1,0,0]\n\t" \
            "v_fma_mix_f32 %[q], %[ry], %[s2], 0 op_sel:[0,0,0] op_sel_hi:[1,0,0]\n\t" \
            "v_fma_mix_f32 %[p], %[rx], %[s1], %[p] op_sel:[1,0,0] op_sel_hi:[1,0,0]\n\t" \
            "v_fma_mix_f32 %[q], %[ry], %[s3], %[q] op_sel:[1,0,0] op_sel_hi:[1,0,0]\n\t" \
            "v_add_f32_e32 %[p], %[p], %[q]\n\t" \
            SC_EXTRA \
            : [p] "+v"(p_), [q] "=&v"(q_), [yr] "+v"(yq), [s0] "+v"(S0), [s1] "+v"(S1), [s2] "+v"(S2), [s3] "+v"(S3), \
              [t0] "+v"(tc0), [t1] "+v"(tc1), [t2] "+v"(tc2), [t3] "+v"(tc3), [n0] "=&v"(n0_), [n1] "=&v"(n1_), [n2] "=&v"(n2_), [n3] "=&v"(n3_) \
            : [vh] "v"(vh##Y), [kx] "v"(kq##Y.x), [ky] "v"(kq##Y.y), [bx] "v"(bq##X.x), [by] "v"(bq##X.y), [rx] "v"(rq##X.x), [ry] "v"(rq##X.y), \
              [ndx] "v"(nd##X.x), [ndy] "v"(nd##X.y)); \
        ykeep = (js == (par) * 8 + (i) - 1) ? yq : ykeep; yq = p_; tc0 = n0_; tc1 = n1_; tc2 = n2_; tc3 = n3_; \
        __builtin_amdgcn_sched_barrier(0); } while (0)
#define SC_EIGHT(buf, par) do { \
        SC_CP(0, par, 0, 1, buf, 1, buf, 2); SC_CP(1, par, 1, 0, buf, 2, buf, 3); SC_CP(0, par, 2, 1, buf, 3, buf, 4); SC_CP(1, par, 3, 0, buf, 4, buf, 5); \
        SC_CP(0, par, 4, 1, buf, 5, buf, 6); SC_CP(1, par, 5, 0, buf, 6, buf, 7); SC_CP(0, par, 6, 1, buf, 7, ((buf) + 1) & 3, 0); SC_CP(1, par, 7, 0, ((buf) + 1) & 3, 0, ((buf) + 1) & 3, 1); } while (0)
#define SC_YOUT(off) do { const float yl_ = allreduce16(yq); ykeep = (js == 15) ? yl_ : ykeep; if (dodma) yp[(size_t)(ch * 8 + (off)) * 512] = (bf16)f2bf(ykeep); yq = 0.f; } while (0)
#define SC_HEAD(k) do { { const int nx = (ch + (k) + 3 < NCH) ? ch + (k) + 3 : NCH - 1; SC_G(nx, ((k) + 3) & 3); } asm volatile("s_waitcnt vmcnt(12)" ::: "memory"); __builtin_amdgcn_sched_barrier(0); } while (0)

__device__ __forceinline__ void scan_unit(const unsigned char* pack, bf16* Y, PG8_LAS unsigned char* ldsw, int unit, int w, int lane, bool dodma) {
    const int xcd_ = unit & 7, idx_ = unit >> 3, bh = xcd_ * 8 + (idx_ >> 2), rg = idx_ & 3, b = bh >> 3, h = bh & 7;
    const int rr = lane >> 4, js = lane & 15, row = rg * 16 + w * 4 + rr;
    const unsigned char* src = pack + (size_t)bh * T * REC;
    bf16* yp = Y + ((size_t)b * T + js) * 512 + h * 64 + row;
    const PG8_LAS unsigned char* pj = ldsw + 8 * js; const PG8_LAS unsigned char* pv = ldsw + 512 + 2 * row; const PG8_LAS unsigned char* pd = ldsw + 640 + 8 * js;
    u32x2 nk0, bq0, kq0, rq0, nk1, bq1, kq1, rq1, nd0, nd1; unsigned vh0, vh1;
    float S0 = 0.f, S1 = 0.f, S2 = 0.f, S3 = 0.f, ykeep = 0.f, yq = 0.f;
    constexpr int NCH = T / 8;
    SC_G(0, 0); SC_G(1, 1); SC_G(2, 2);
    asm volatile("s_waitcnt vmcnt(12)" ::: "memory");
    SC_RD(0, 0, 0); SC_RDK(0, 0, 0); SC_RDK(1, 0, 1);
    float tc0 = mix2z_ll(vh0, kq0.x), tc1 = mix2z_lh(vh0, kq0.x), tc2 = mix2z_ll(vh0, kq0.y), tc3 = mix2z_lh(vh0, kq0.y);
    __builtin_amdgcn_sched_barrier(0);
#pragma unroll 1
    for (int ch = 0; ch < NCH; ch += 4) {
        SC_HEAD(0); SC_EIGHT(0, 0);
        SC_HEAD(1); SC_EIGHT(1, 1);
        SC_YOUT(0);
        SC_HEAD(2); SC_EIGHT(2, 0);
        SC_HEAD(3); SC_EIGHT(3, 1);
        SC_YOUT(16);
    }
    asm volatile("s_waitcnt vmcnt(0)" ::: "memory");
}

#if defined(PROBE_FAKE)
__device__ __forceinline__ void scan_fake(bf16* Y, PG8_LAS unsigned char* ldsw, int lane, int nch) {
    const int js = lane & 15, row = lane >> 4;
    const PG8_LAS unsigned char* pj = ldsw + 8 * js; const PG8_LAS unsigned char* pv = ldsw + 512 + 2 * row; const PG8_LAS unsigned char* pd = ldsw + 640 + 16 * js;
    u32x2 nk0, bq0, kq0, rq0, nk1, bq1, kq1, rq1; unsigned vh0, vh1; f32x4 dd0, dd1;
    float S0 = 0.f, S1 = 0.f, S2 = 0.f, S3 = 0.f, ykeep = 0.f, yq = 0.f;
    SC_RD(0, 0, 0);
    float tc0 = 0.f, tc1 = 0.f, tc2 = 0.f, tc3 = 0.f;
#pragma unroll 1
    for (int ch = 0; ch < nch; ch += 4) { SC_EIGHT(0, 0); SC_EIGHT(1, 1); SC_EIGHT(2, 0); SC_EIGHT(3, 1); }
    if (S0 + S1 + S2 + S3 + ykeep + yq == 1.2345e30f) Y[lane] = (bf16)1;
}
#endif

__device__ __forceinline__ void attn_item(const bf16* QK, const bf16* VT, bf16* OAB, const float* tab, int item, int lane) {
    const int qh = item & 1, cq = (item >> 1) & 63, bh = item >> 7, b = bh >> 3, h = bh & 7;
    const int n = lane & 31, hi = lane >> 5;
    const size_t mq = (size_t)b * T + cq * 64 + qh * 32 + n;
    bf16x8 bq[4];
#pragma unroll
    for (int s = 0; s < 4; ++s) bq[s] = *(const bf16x8*)(QK + mq * 1024 + h * 64 + 16 * s + 8 * hi);
    f32x16 o0, o1;
#pragma unroll
    for (int i = 0; i < 16; ++i) { o0[i] = 0.f; o1[i] = 0.f; }
    float mrun = -1e30f, lrun = 0.f;
    const int pin = (n & ~12) | ((n & 4) << 1) | ((n & 8) >> 1);
    const float* tabh = tab + h * 256; const float c191 = tabh[191];
    for (int j = (cq < 8 ? 8 - cq : 0); j <= 8; ++j) {
        const int kc = cq - 8 + j; const size_t mk0 = (size_t)b * T + (size_t)kc * 64;
        f32x16 x0, x1;
#pragma unroll
        for (int i = 0; i < 16; ++i) { x0[i] = 0.f; x1[i] = 0.f; }
        const bf16* kp0 = QK + (mk0 + pin) * 1024 + 512 + h * 64 + 8 * hi;
#pragma unroll
        for (int s = 0; s < 4; ++s) { const bf16x8 a0 = *(const bf16x8*)(kp0 + 16 * s), a1 = *(const bf16x8*)(kp0 + 32 * 1024 + 16 * s); x0 = MFMA32(a0, bq[s], x0); x1 = MFMA32(a1, bq[s], x1); }
        if (j <= 5) {
#pragma unroll
            for (int i = 0; i < 16; ++i) { x0[i] += c191; x1[i] += c191; }
        } else {
            const float* lp = tabh + (32 * qh + n - 8 * hi + 64 * (8 - j) + 8);
#pragma unroll
            for (int i = 0; i < 16; ++i) { const int ct = 16 * (i >> 3) + 4 * ((i >> 2) & 1) + (i & 3); x0[i] += lp[55 - ct]; x1[i] += lp[23 - ct]; }
        }
        float mx = fmaxf(x0[0], x1[0]);
#pragma unroll
        for (int i = 1; i < 16; ++i) mx = fmaxf(mx, fmaxf(x0[i], x1[i]));
        mx = fmaxf(mx, __shfl_xor(mx, 32));
        const float mnew = fmaxf(mrun, mx), alpha = __builtin_amdgcn_exp2f(mrun - mnew); mrun = mnew;
        float ls = 0.f;
#pragma unroll
        for (int i = 0; i < 16; ++i) { x0[i] = __builtin_amdgcn_exp2f(x0[i] - mnew); x1[i] = __builtin_amdgcn_exp2f(x1[i] - mnew); ls += x0[i] + x1[i]; }
        lrun = lrun * alpha + ls;
#pragma unroll
        for (int i = 0; i < 16; ++i) { o0[i] *= alpha; o1[i] *= alpha; }
        const bf16* vp = VT + ((size_t)(bh * 64 + n)) * T + (size_t)kc * 64 + 8 * hi;
#pragma unroll
        for (int s2 = 0; s2 < 2; ++s2) {
            { const bf16x8 v0 = *(const bf16x8*)(vp + 16 * s2), v1 = *(const bf16x8*)(vp + (size_t)32 * T + 16 * s2); const bf16x8 pb = packstep(x0, s2); o0 = MFMA32(v0, pb, o0); o1 = MFMA32(v1, pb, o1); }
            { const bf16x8 v0 = *(const bf16x8*)(vp + 32 + 16 * s2), v1 = *(const bf16x8*)(vp + (size_t)32 * T + 32 + 16 * s2); const bf16x8 pb = packstep(x1, s2); o0 = MFMA32(v0, pb, o0); o1 = MFMA32(v1, pb, o1); }
        }
    }
    lrun += __shfl_xor(lrun, 32); const float inv = 1.f / lrun;
    bf16* op = OAB + mq * 1024 + 512 + h * 64 + 4 * hi;
#pragma unroll
    for (int g = 0; g < 4; ++g) {
        u32x2 w0, w1; w0.x = cvtpk(o0[4 * g] * inv, o0[4 * g + 1] * inv); w0.y = cvtpk(o0[4 * g + 2] * inv, o0[4 * g + 3] * inv);
        w1.x = cvtpk(o1[4 * g] * inv, o1[4 * g + 1] * inv); w1.y = cvtpk(o1[4 * g + 2] * inv, o1[4 * g + 3] * inv);
        *(u32x2*)(op + 8 * g) = w0; *(u32x2*)(op + 32 + 8 * g) = w1;
    }
}

__device__ __forceinline__ void phase3(const P& p, const Ctx& c) {
    unsigned char* ws = p.ws;
    float* tab = (float*)(c.lds + 4 * 4 * CHB);
    for (int i = c.tid; i < NH * 256; i += NTHR) { const int h = i >> 8, r = i & 255; tab[i] = p.in[I_REL][h * 192 + (r < 191 ? r : 191)] * LOG2E; }
    __syncthreads();
    if (c.wave < 4) {
        __builtin_amdgcn_s_setprio(3);
#ifndef PROBE_SCAN
#define PROBE_SCAN 1
#endif
        for (int rp_ = 0; rp_ < PROBE_SCAN; ++rp_)
        for (int unit = blockIdx.x; unit < 256; unit += c.G)
            scan_unit(ws + WS_PACK, (bf16*)((unsigned char*)p.out + O_Y), (PG8_LAS unsigned char*)c.lds + c.wave * (4 * CHB), unit, c.wave, c.lane, rp_ == 0);
        __builtin_amdgcn_s_setprio(0);
    } else {
        const int aw = blockIdx.x * 4 + (c.wave - 4), NAW = c.G * 4;
#ifndef PROBE_ATT
#define PROBE_ATT 1
#endif
        for (int rp_ = 0; rp_ < PROBE_ATT; ++rp_)
        for (int kb = 0; kb < 8; ++kb) {
            const int xcd_ = blockIdx.x & 7, lw = (blockIdx.x >> 3) * 4 + (c.wave - 4), bh_ = xcd_ * 8 + kb;
            attn_item((const bf16*)(ws + WS_QK), (const bf16*)((unsigned char*)p.out + O_VT), (bf16*)(ws + WS_OAB), tab, bh_ * 128 + lw, c.lane);
        }
        {
          float* scr = (float*)(c.lds + 4 * 4 * CHB + 8192 + (c.wave - 4) * 4224);
          constexpr int J1 = 32 * 64, J2 = 32 * 176, J3 = 88 * 32, J4 = 32 * 32, J5 = 16 * 32, J6 = 16 * 32, J7 = 32 * 32, J8 = 8 * 32;
          constexpr int NJ = J1 + J2 + J3 + J4 + J5 + J6 + J7 + J8;
          for (int it = aw; it < NJ; it += NAW) {
              int r = it;
              if (r < J1) { p0_transpose_item<32>(p.in[I_WIN], D, 5376, (bf16*)(ws + WS_WIN), D, 0, 0, 2, p.in[I_LN1], scr, r, c.lane, 104, 64); continue; } r -= J1;
              if (r < J2) { p0_transpose_item<32>(p.in[I_WUP], D, NUP, (bf16*)(ws + WS_WUP), D, 0, 0, true, p.in[I_LN2], scr, r, c.lane); continue; } r -= J2;
              if (r < J3) { p0_transpose_item<32>(p.in[I_WDOWN], DFF, D, (bf16*)(ws + WS_WDOWN), DFF, 0, 0, false, nullptr, scr, r, c.lane); continue; } r -= J3;
              if (r < J4) { p0_transpose_item<32>(p.in[I_WO], D, D, (bf16*)(ws + WS_WO), D, 0, 0, false, nullptr, scr, r, c.lane); continue; } r -= J4;
              if (r < J5) { p0_transpose_item<32>(p.in[I_WBRR], 512, D, (bf16*)(ws + WS_WBR), D, 0, 0, false, nullptr, scr, r, c.lane); continue; } r -= J5;
              if (r < J6) { p0_transpose_item<32>(p.in[I_WBRA], 512, D, (bf16*)(ws + WS_WBR), D, 512, 0, false, nullptr, scr, r, c.lane); continue; } r -= J6;
              if (r < J7) { p0_transpose_item<32>(p.in[I_WPG], D, D, (bf16*)(ws + WS_WPG), D, 0, 0, false, p.in[I_LN3], scr, r, c.lane); continue; } r -= J7;
              p0_transpose_item<32>(p.in[I_WPLE], PLED, D, (bf16*)(ws + WS_WPLE), PLED, 0, 0, false, nullptr, scr, r, c.lane);
          } }
        {
          const f32x4* pp = (const f32x4*)p.in[I_P]; u32x2* pb = (u32x2*)(ws + WS_PB); const int stride = NAW * 64, total = M * PLED / 4;
          for (int i = aw * 64 + c.lane; i + 3 * stride < total; i += 4 * stride) {
              const f32x4 v0 = __builtin_nontemporal_load(pp + i), v1 = __builtin_nontemporal_load(pp + i + stride), v2 = __builtin_nontemporal_load(pp + i + 2 * stride), v3 = __builtin_nontemporal_load(pp + i + 3 * stride);
              u32x2 o; o.x = pk2(v0.x, v0.y); o.y = pk2(v0.z, v0.w); pb[i] = o; o.x = pk2(v1.x, v1.y); o.y = pk2(v1.z, v1.w); pb[i + stride] = o;
              o.x = pk2(v2.x, v2.y); o.y = pk2(v2.z, v2.w); pb[i + 2 * stride] = o; o.x = pk2(v3.x, v3.y); o.y = pk2(v3.z, v3.w); pb[i + 3 * stride] = o; } }
#if defined(PROBE_FAKE)
        scan_fake((bf16*)((unsigned char*)p.out + O_Y), (PG8_LAS unsigned char*)c.lds + (c.wave - 4) * 28672, c.lane, PROBE_FAKE);
#endif
    }
}

__device__ __forceinline__ void phase35a(const P& p, const Ctx& c) {
    unsigned char* ws = p.ws;
    const bf16* Y = (const bf16*)((unsigned char*)p.out + O_Y); const bf16* Gm = (const bf16*)((unsigned char*)p.out + O_G);
    const unsigned char* PACK = ws + WS_PACK; const float* BONUS = (const float*)(ws + WS_BONUS); bf16* OAB = (bf16*)(ws + WS_OAB);
    const int hq = c.lane >> 4, js = c.lane & 15;
    for (int wi = c.gw; wi < 2048; wi += c.NGW) {
        const int hh = wi & 1, chunk = wi >> 1, h = 4 * hh + hq, col = h * 64 + 4 * js, mb = chunk * 32, b = mb / T, t0 = mb % T;
        const f32x4 lw = *(const f32x4*)(p.in[I_LNXW] + col), lb = *(const f32x4*)(p.in[I_LNXB] + col);
        const unsigned char* rec = PACK + ((size_t)((b * NH + h) * T + t0)) * REC + 512 + 8 * js;
#pragma unroll 8
        for (int i = 0; i < 32; ++i) {
            const size_t m = (size_t)(mb + i);
            const u32x2 y_ = *(const u32x2*)(Y + m * 512 + col), g_ = *(const u32x2*)(Gm + m * 512 + col), v_ = *(const u32x2*)(rec + (size_t)i * REC);
            const f32x4 y = {bflo(y_.x), bfhi(y_.x), bflo(y_.y), bfhi(y_.y)}, g = {bflo(g_.x), bfhi(g_.x), bflo(g_.y), bfhi(g_.y)};
            const h4 vh = __builtin_bit_cast(h4, v_); const f32x4 v = {(float)vh.x, (float)vh.y, (float)vh.z, (float)vh.w};
            const float mean = allreduce16((y.x + y.y) + (y.z + y.w)) * (1.f / 64); const f32x4 dy = y - mean;
            const float var = allreduce16((dy.x * dy.x + dy.y * dy.y) + (dy.z * dy.z + dy.w * dy.w)) * (1.f / 64);
            const f32x4 o = (dy * rsqrtf(var + GN_EPS) * lw + lb + v * BONUS[m * NH + h]) * g;
            u32x2 w; w.x = pk2(o.x, o.y); w.y = pk2(o.z, o.w); *(u32x2*)(OAB + m * 1024 + col) = w;
        }
    }
}

__device__ __forceinline__ void phase5b(const P& p, const Ctx& c, int wr) {
    bf16* U = (bf16*)(p.ws + WS_U);
    const float* cw = p.in[I_CONVW]; const float* cb = p.in[I_CONVB];
    constexpr int RUN = 16, NCH16 = DFF / 8;
    const int total = (M / RUN) * NCH16;
    for (int it = blockIdx.x * NTHR + c.tid; it < total; it += c.G * NTHR) {
        const int run = it / NCH16, ck = it % NCH16, ch0 = ck * 8, blk = ch0 >> 7, j0 = ch0 & 127;
        const int m0 = run * RUN, t0 = m0 & (T - 1);
        float w0[8], w1[8], w2[8], bb[8];
#pragma unroll
        for (int e = 0; e < 8; ++e) { w0[e] = cw[ch0 + e]; w1[e] = cw[DFF + ch0 + e]; w2[e] = cw[2 * DFF + ch0 + e]; bb[e] = cb[ch0 + e]; }
        bf16* ua = U + (size_t)m0 * NUP + 256 * blk + j0;
        float a1[8], a2[8];
        if (t0 == 0) {
#pragma unroll
            for (int e = 0; e < 8; ++e) { a1[e] = 0.f; a2[e] = 0.f; }
        } else {
            f32x4 x0, x1; unpack8(*(const u32x4*)(ua - NUP), x0, x1); f32x4 y0, y1; unpack8(*(const u32x4*)(ua - 2 * NUP), y0, y1);
#pragma unroll
            for (int e = 0; e < 4; ++e) { a1[e] = x0[e]; a1[4 + e] = x1[e]; a2[e] = y0[e]; a2[4 + e] = y1[e]; }
        }
#pragma unroll 4
        for (int i = 0; i < RUN; ++i) {
            bf16* ur = ua + (size_t)i * NUP;
            f32x4 x0, x1, g0, g1; unpack8(*(const u32x4*)ur, x0, x1); unpack8(*(const u32x4*)(ur + 128), g0, g1);
            float a0[8], r[8];
#pragma unroll
            for (int e = 0; e < 4; ++e) { a0[e] = x0[e]; a0[4 + e] = x1[e]; }
#pragma unroll
            for (int e = 0; e < 8; e += 2) {
                f32x2 cv; cv.x = bb[e] + w0[e] * a2[e] + w1[e] * a1[e] + w2[e] * a0[e]; cv.y = bb[e + 1] + w0[e + 1] * a2[e + 1] + w1[e + 1] * a1[e + 1] + w2[e + 1] * a0[e + 1];
                const f32x2 ge = pg8::gelu_pk(cv); r[e] = ge.x; r[e + 1] = ge.y;
            }
#pragma unroll
            for (int e = 0; e < 8; ++e) { a2[e] = a1[e]; a1[e] = a0[e]; }
            f32x4 r0 = {r[0] * g0[0], r[1] * g0[1], r[2] * g0[2], r[3] * g0[3]}, r1 = {r[4] * g1[0], r[5] * g1[1], r[6] * g1[2], r[7] * g1[3]};
            if (wr) *(u32x4*)(ur + 128) = pack8(r0, r1);
        }
    }
}

__device__ __forceinline__ void phase5b_fix(const P& p, const Ctx& c) {
    bf16* ACT = (bf16*)(p.ws + WS_U); const bf16* ARAW = ACT + (size_t)M * DFF;
    const float* cw = p.in[I_CONVW]; const float* cb = p.in[I_CONVB];
    constexpr int NCH16 = DFF / 8;
    const int total = (M / 32) * NCH16;
    for (int it = blockIdx.x * NTHR + c.tid; it < total; it += c.G * NTHR) {
        const int rid = it / NCH16, ck = it % NCH16, ch0 = ck * 8;
        const int m = (rid >> 1) * 64 + (rid & 1), t = m & (T - 1), slot = 4 * (m >> 6) + (m & 63);
        bf16* ur = ACT + (size_t)m * DFF + ch0; const bf16* ar = ARAW + (size_t)slot * DFF + ch0;
        f32x4 x0, x1, g0, g1, y0 = {0.f, 0.f, 0.f, 0.f}, y1 = y0, z0 = y0, z1 = y0;
        unpack8(*(const u32x4*)ar, x0, x1); unpack8(*(const u32x4*)ur, g0, g1);
        if (t >= 1) unpack8(*(const u32x4*)(ar - DFF), y0, y1);
        if (t >= 2) unpack8(*(const u32x4*)(ar - 2 * DFF), z0, z1);
        const f32x4 w00 = *(const f32x4*)(cw + ch0), w01 = *(const f32x4*)(cw + ch0 + 4), w10 = *(const f32x4*)(cw + DFF + ch0), w11 = *(const f32x4*)(cw + DFF + ch0 + 4);
        const f32x4 w20 = *(const f32x4*)(cw + 2 * DFF + ch0), w21 = *(const f32x4*)(cw + 2 * DFF + ch0 + 4), b0 = *(const f32x4*)(cb + ch0), b1 = *(const f32x4*)(cb + ch0 + 4);
        const f32x4 c0 = b0 + w00 * z0 + w10 * y0 + w20 * x0, c1 = b1 + w01 * z1 + w11 * y1 + w21 * x1;
        const f32x2 e0 = pg8::gelu_pk((f32x2){c0[0], c0[1]}), e1 = pg8::gelu_pk((f32x2){c0[2], c0[3]}), e2 = pg8::gelu_pk((f32x2){c1[0], c1[1]}), e3 = pg8::gelu_pk((f32x2){c1[2], c1[3]});
        const f32x4 r0 = {e0.x * g0[0], e0.y * g0[1], e1.x * g0[2], e1.y * g0[3]}, r1 = {e2.x * g1[0], e2.y * g1[1], e3.x * g1[2], e3.y * g1[3]};
        *(u32x4*)ur = pack8(r0, r1);
    }
}

__device__ __forceinline__ void phase8(const P& p, const Ctx& c, int wr) {
    const float* SSF = (const float*)(p.ws + WS_SSF); const f32x4* gf = (const f32x4*)p.in[I_LNF] + c.lane;
    const bf16* X3 = (const bf16*)(p.ws + WS_X3);
    f32x4 g[4];
#pragma unroll
    for (int j = 0; j < 4; ++j) g[j] = gf[64 * j];
    for (int m = c.gw; m < M; m += 2 * c.NGW) {
        const int m2 = m + c.NGW;
        const float rs = rsqrtf(SSF[m] * (1.f / D) + NORM_EPS), rs2 = rsqrtf(SSF[m2] * (1.f / D) + NORM_EPS);
        const u32x2* xr = (const u32x2*)(X3 + (size_t)m * D) + c.lane; const u32x2* xq = (const u32x2*)(X3 + (size_t)m2 * D) + c.lane;
        f32x4* orow = (f32x4*)(p.out + (size_t)m * D) + c.lane; f32x4* oq = (f32x4*)(p.out + (size_t)m2 * D) + c.lane;
        u32x2 v[4], w[4];
#pragma unroll
        for (int j = 0; j < 4; ++j) { v[j] = xr[64 * j]; w[j] = xq[64 * j]; }
#pragma unroll
        for (int j = 0; j < 4; ++j) {
            const f32x4 a = {bflo(v[j].x), bfhi(v[j].x), bflo(v[j].y), bfhi(v[j].y)}, b = {bflo(w[j].x), bfhi(w[j].x), bflo(w[j].y), bfhi(w[j].y)};
            if (wr) { __builtin_nontemporal_store(a * rs * g[j], orow + 64 * j); __builtin_nontemporal_store(b * rs2 * g[j], oq + 64 * j); }
        }
    }
}

constexpr int NPHASE = 16;
__global__ void __launch_bounds__(NTHR, 2) mk_fwd(P p) {
    extern __shared__ __attribute__((aligned(16))) unsigned char lds[];
    cg::grid_group grid = cg::this_grid();
    const int wave_s = __builtin_amdgcn_readfirstlane((int)(threadIdx.x >> 6));
    volatile PG8_LAS unsigned* misc = (volatile PG8_LAS unsigned*)((PG8_LAS unsigned char*)lds + LDS_BYTES - 256);
    if (threadIdx.x < 32) misc[threadIdx.x] = 0u;
    __syncthreads();
    if (p.ph_lo < 0) grid.sync();
    const XcdBarrier xbar = xcd_barrier_post((unsigned*)(p.ws + WS_BAR), misc + 8);
#define MKCTX Ctx c; c.lds = lds; c.lane = vlane_id(); c.wave = wave_s; c.tid = wave_s * 64 + c.lane; c.G = gridDim.x; c.gw = blockIdx.x * NWAVES + c.wave; c.NGW = c.G * NWAVES;
    unsigned char* ws = p.ws; unsigned char* ob = (unsigned char*)p.out;
    PG8_LAS unsigned char* ring = (PG8_LAS unsigned char*)lds;
    const int lo = p.ph_lo, hi = p.ph_hi;
#ifndef FUSE_ALIGN
#define FUSE_ALIGN true
#endif
#ifndef PROBE_REP
#define PROBE_REP 0
#endif
#ifndef PROBE_BAR2
#define PROBE_BAR2 0
#endif
#define REPS(k) (1 + ((PROBE_REP >> (k)) & 1))
#ifndef PH_MASK
#define PH_MASK 0xFFFF
#endif
#define IN(k) (((PH_MASK >> (k)) & 1) && lo <= (k) && (k) < hi)
#define SEAM(k) do { if (IN(k) && IN((k) + 1)) { { xcd_barrier(xbar, wave_s * 64 + vlane_id()); if (PROBE_BAR2) xcd_barrier(xbar, wave_s * 64 + vlane_id()); } } } while (0)
    typedef pg8::StaticOrder SO;
    if (IN(0)) for (int rep_ = 0; rep_ < REPS(0); ++rep_) { MKCTX phase0(p, c); } SEAM(0);
    if (IN(1)) for (int rep_ = 0; rep_ < REPS(1); ++rep_) {
        { pg8::Gemm g{(const bf16*)(ws + WS_XB), (const bf16*)(ws + WS_WIN), M, 2816, D, D, 256}; SO S; S.init(M, 2816, gridDim.x, blockIdx.x);
          EpiZ E{(bf16*)(ws + WS_ZRM), (bf16*)(ws + WS_ZLOW), (bf16*)(ws + WS_QK), (bf16*)(ws + WS_V)};
          pg8::gemm_phase<EpiZ, SO, true>(ring, g, S, E, wave_s, vlane_id()); }
        {
          pg8::Gemm g{(const bf16*)(ws + WS_WIN) + (size_t)2816 * D, (const bf16*)(ws + WS_XB), 512, M, D, D, 256}; SO S; S.init(512, M, gridDim.x, blockIdx.x);
          EpiVT E{(bf16*)(ob + O_VT)};
          pg8::gemm_phase<EpiVT, SO, true>(ring, g, S, E, wave_s, vlane_id()); } } SEAM(1);
    if (IN(2)) for (int rep_ = 0; rep_ < REPS(2); ++rep_) { MKCTX phase2a(p, c); } SEAM(2);
    if (IN(3)) for (int rep_ = 0; rep_ < REPS(3); ++rep_) { pg8::Gemm g{(const bf16*)(ob + O_A2), (const bf16*)(ws + WS_BT2), M, 1536, 256, 256, 256}; SO S; S.init(M, 1536, gridDim.x, blockIdx.x);
        EpiLR E{ws + WS_PACK, (bf16*)(ob + O_A), (bf16*)(ob + O_G), p.in[I_W0], p.in[I_A0]};
        pg8::gemm_phase<EpiLR, SO, true>(ring, g, S, E, wave_s, vlane_id()); } SEAM(3);
    if (IN(4)) for (int rep_ = 0; rep_ < REPS(4); ++rep_) { MKCTX phase2c(p, c); } SEAM(4);
    if (IN(5)) for (int rep_ = 0; rep_ < REPS(5); ++rep_) { MKCTX phase3(p, c); } SEAM(5);
    if (IN(6)) for (int rep_ = 0; rep_ < REPS(6); ++rep_) { MKCTX phase35a(p, c); } SEAM(6);
    if (IN(7)) for (int rep_ = 0; rep_ < REPS(7); ++rep_) { pg8::Gemm g{(const bf16*)(ws + WS_XB), (const bf16*)(ws + WS_WIN) + (size_t)ZMAIN * D, M, NGATE, D, D, 256}; SO S; S.init(M, NGATE, gridDim.x, blockIdx.x);
        EpiGate E{(bf16*)(ws + WS_GATES), p.in[I_GATEB]};
        pg8::gemm_phase<EpiGate, SO, true>(ring, g, S, E, wave_s, vlane_id()); } SEAM(7);
    if (IN(8)) for (int rep_ = 0; rep_ < REPS(8); ++rep_) { pg8::Gemm g{(const bf16*)(ws + WS_OAB), (const bf16*)(ws + WS_WBR), M, D, D, D, 256}; SO S; S.init(M, D, gridDim.x, blockIdx.x);
        EpiMerge E{(const bf16*)(ws + WS_GATES), (bf16*)(ws + WS_MERGED)};
        pg8::gemm_phase<EpiMerge, SO, true>(ring, g, S, E, wave_s, vlane_id()); } SEAM(8);
    if (IN(9)) for (int rep_ = 0; rep_ < REPS(9); ++rep_) { pg8::Gemm g{(const bf16*)(ws + WS_MERGED), (const bf16*)(ws + WS_WO), M, D, D, D, 256}; SO S; S.init(M, D, gridDim.x, blockIdx.x);
        EpiRes E{p.in[I_X], (bf16*)(ws + WS_XB), (float*)(ws + WS_SS2), rep_ == REPS(9) - 1};
        pg8::gemm_phase<EpiRes, SO, true>(ring, g, S, E, wave_s, vlane_id()); } SEAM(9);
    if (IN(10)) for (int rep_ = 0; rep_ < REPS(10); ++rep_) { pg8::Gemm g{(const bf16*)(ws + WS_XB), (const bf16*)(ws + WS_WUP), M, NUP, D, D, 256}; SO S; S.init(M, NUP, gridDim.x, blockIdx.x);
        EpiUpAct E{(bf16*)(ws + WS_U), (const float*)(ws + WS_SS2), p.in[I_CONVW], p.in[I_CONVB]};
        pg8::gemm_phase<EpiUpAct, SO, FUSE_ALIGN>(ring, g, S, E, wave_s, vlane_id()); } SEAM(10);
    if (IN(11)) { { MKCTX phase5b_fix(p, c); }
        pg8::Gemm g{(const bf16*)(ws + WS_PB), (const bf16*)(ws + WS_WPLE), M, D, PLED, PLED, 256}; SO S; S.init(M, D, gridDim.x, blockIdx.x);
        EpiPlain E{(bf16*)ob, D};
        pg8::gemm_phase<EpiPlain, SO, true>(ring, g, S, E, wave_s, vlane_id()); } SEAM(11);
    if (IN(12)) for (int rep_ = 0; rep_ < REPS(12); ++rep_) { pg8::Gemm g{(const bf16*)(ws + WS_U), (const bf16*)(ws + WS_WDOWN), M, D, DFF, DFF, 256}; SO S; S.init(M, D, gridDim.x, blockIdx.x);
        EpiResB E{(bf16*)(ws + WS_XB), (float*)(ws + WS_SS3), rep_ == REPS(12) - 1};
        pg8::gemm_phase<EpiResB, SO, true>(ring, g, S, E, wave_s, vlane_id()); } SEAM(12);
    if (IN(14)) for (int rep_ = 0; rep_ < REPS(14); ++rep_) { pg8::Gemm g{(const bf16*)(ws + WS_XB), (const bf16*)(ws + WS_WPG), M, D, D, D, 256}; SO S; S.init(M, D, gridDim.x, blockIdx.x);
        EpiFinal E{(bf16*)(ws + WS_X3), (const bf16*)(ws + WS_XB), (const bf16*)ob, (const float*)(ws + WS_SS3), p.in[I_BPG], (float*)(ws + WS_SSF), rep_ == REPS(14) - 1};
        pg8::gemm_phase<EpiFinal, SO, true>(ring, g, S, E, wave_s, vlane_id()); } SEAM(14);
    if (IN(15)) for (int rep_ = 0; rep_ < REPS(15); ++rep_) { MKCTX phase8(p, c, rep_ == REPS(15) - 1); }
#undef IN
#undef SEAM
}

#ifndef MK_PER_PHASE
#define MK_PER_PHASE 0
#endif
extern "C" void kernel_launch(void* const* d_in, const int* in_sizes, int n_in, void* d_out, int out_size, void* d_ws, size_t ws_size, hipStream_t stream) {
    static int grid = 0;
    if (grid == 0) {
        if (n_in != 30 || out_size != M * D || ws_size < WS_END) { fprintf(stderr, "kernel_launch: unexpected shapes (n_in %d out %d ws %zu)\n", n_in, out_size, ws_size); grid = -1; return; }
        int dev = 0, cus = 0, per_cu = 0;
        hipGetDevice(&dev); hipDeviceGetAttribute(&cus, hipDeviceAttributeMultiprocessorCount, dev);
        hipFuncSetAttribute((const void*)mk_fwd, hipFuncAttributeMaxDynamicSharedMemorySize, LDS_BYTES);
        hipOccupancyMaxActiveBlocksPerMultiprocessor(&per_cu, (const void*)mk_fwd, NTHR, LDS_BYTES);
        if (per_cu < 1) { fprintf(stderr, "kernel_launch: occupancy query says %d blocks/CU\n", per_cu); per_cu = 1; }
        grid = cus * (per_cu > 1 ? 1 : per_cu);
        if (grid > 256) grid = 256;
        if (grid != 256) { fprintf(stderr, "kernel_launch: this kernel is laid out for 256 co-resident workgroups; got %d\n", grid); grid = -1; return; }
        if ((M % (4 * grid * NWAVES)) != 0) { fprintf(stderr, "kernel_launch: grid %d does not divide the row count\n", grid); grid = -1; return; }
    }
    if (grid < 0) return;
    hipMemsetAsync(d_ws, 0, CTL_BYTES, stream);
    P p{};
    for (int i = 0; i < 30; ++i) p.in[i] = (const float*)d_in[i];
    p.out = (float*)d_out; p.ws = (unsigned char*)d_ws;
#if MK_PER_PHASE
    for (int k = 0; k < NPHASE; ++k) { p.ph_lo = k; p.ph_hi = k + 1; hipLaunchKernelGGL(mk_fwd, dim3(grid), dim3(NTHR), LDS_BYTES, stream, p); }
#else
    p.ph_lo = 0; p.ph_hi = NPHASE;
    void* args[] = {&p};
    hipError_t e = hipLaunchCooperativeKernel((const void*)mk_fwd, dim3(grid), dim3(NTHR), args, LDS_BYTES, stream);
    if (e != hipSuccess) fprintf(stderr, "cooperative launch failed: %s (grid %d)\n", hipGetErrorString(e), grid);
#endif
}
```
